# Optimizing an MI355X kernel written in HIP

```python
import jax, jax.numpy as jnp
from jax import lax
import numpy as np

D_MODEL = 2048
BATCH = 8
SEQ = 2048
DEPTH = 1

CHUNK = 64
N_MEM = 256
EPS = 1e-6
SB_HEAD_DIM = 128
SB_WIDTH = D_MODEL // 2
SB_HEADS = SB_WIDTH // SB_HEAD_DIM
SB_BLOCK = 128
SSM_INNER = D_MODEL // 2
SSM_HEAD_DIM = 64
SSM_HEADS = SSM_INNER // SSM_HEAD_DIM
SSM_GROUPS = 4
SSM_STATE = 128
SSM_CONV = 4
SSM_CHUNK = CHUNK
CONV_DIM = SSM_INNER + 2 * SSM_GROUPS * SSM_STATE
MIX_WIDTH = SB_WIDTH + SSM_INNER
IN_PROJ_DIM = 3 * SB_WIDTH + SSM_INNER + CONV_DIM + SSM_HEADS
MEM_HEADS = 4
MEM_HEAD_DIM = 128
MEM_WIDTH = MEM_HEADS * MEM_HEAD_DIM
D_FF = ((8 * D_MODEL // 3 + 127) // 128) * 128

kernel_name = "hybrid_sb_ssd_macaron_memory_layer"


def rms_norm(x, w):
    x32 = x.astype(jnp.float32)
    y = x32 * lax.rsqrt(jnp.mean(x32 * x32, axis=-1, keepdims=True) + EPS)
    return (y * w.astype(jnp.float32)).astype(x.dtype)


def swiglu(x, wg, wu, wd):
    return (jax.nn.silu(x @ wg) * (x @ wu)) @ wd


def stick_breaking(q, k, v):
    b, h, s, d = q.shape
    nblk = s // SB_BLOCK
    scale = d ** -0.5
    qb = q.reshape(b, h, nblk, SB_BLOCK, d).transpose(2, 0, 1, 3, 4)
    k32 = k.astype(jnp.float32)
    kpos = jnp.arange(s)

    def block(args):
        i, qi = args
        z = jnp.einsum('bhqd,bhkd->bhqk', qi.astype(jnp.float32), k32) * scale
        qpos = i * SB_BLOCK + jnp.arange(SB_BLOCK)
        mask = kpos[None, :] < qpos[:, None]
        log_keep = jnp.where(mask, jax.nn.log_sigmoid(-z), 0.0)
        tail = lax.cumsum(log_keep, axis=3, reverse=True)
        tail_excl = jnp.concatenate([tail[..., 1:], jnp.zeros_like(tail[..., :1])], axis=-1)
        log_a = jnp.where(mask, jax.nn.log_sigmoid(z) + tail_excl, -jnp.inf)
        a = jnp.exp(log_a)
        return jnp.einsum('bhqk,bhkd->bhqd', a.astype(v.dtype), v)

    out = lax.map(block, (jnp.arange(nblk), qb))
    return out.transpose(1, 2, 0, 3, 4).reshape(b, h, s, d)


def causal_dwconv(x, w, bias):
    kw = w.shape[0]
    y = lax.conv_general_dilated(x, w[:, None, :], window_strides=(1,), padding=[(kw - 1, 0)],
                                 dimension_numbers=('NWC', 'WIO', 'NWC'),
                                 feature_group_count=x.shape[-1])
    return y + bias


def segsum_exp(a):
    l = a.shape[-1]
    cs = jnp.cumsum(a, axis=-1)
    diff = cs[..., :, None] - cs[..., None, :]
    mask = jnp.tril(jnp.ones((l, l), dtype=bool))
    return jnp.exp(jnp.where(mask, diff, -jnp.inf))


def ssd(x, dt, a, bm, cm):
    b, s, h, p = x.shape
    g, n = bm.shape[2], bm.shape[3]
    r = h // g
    l = SSM_CHUNK
    c = s // l
    xd = (x * dt[..., None]).reshape(b, c, l, g, r, p)
    da = (dt * a).reshape(b, c, l, g, r).transpose(0, 1, 3, 4, 2)
    bm = bm.reshape(b, c, l, g, n)
    cm = cm.reshape(b, c, l, g, n)
    da_cs = jnp.cumsum(da, axis=-1)
    decay = segsum_exp(da)
    cb = jnp.einsum('bclgn,bcsgn->bcgls', cm, bm)
    y_diag = jnp.einsum('bcgrls,bcsgrp->bclgrp', cb[:, :, :, None] * decay, xd)
    decay_to_end = jnp.exp(da_cs[..., -1:] - da_cs)
    states = jnp.einsum('bclgn,bcgrl,bclgrp->bcgrpn', bm, decay_to_end, xd)
    chunk_decay = jnp.exp(da_cs[..., -1])

    def step(carry, inp):
        st, dec = inp
        return carry * dec[..., None, None] + st, carry

    init = jnp.zeros((b, g, r, p, n), jnp.float32)
    _, prev = lax.scan(step, init, (states.transpose(1, 0, 2, 3, 4, 5), chunk_decay.transpose(1, 0, 2, 3)))
    prev = prev.transpose(1, 0, 2, 3, 4, 5)
    y_off = jnp.einsum('bclgn,bcgrpn,bcgrl->bclgrp', cm, prev, jnp.exp(da_cs))
    return (y_diag + y_off).reshape(b, s, h, p)


def parallel_mixer(h, pre, w_in, conv_w, conv_b, dt_bias, a_log, d_skip, sb_norm, ssm_norm, w_out, post):
    b, s, _ = h.shape
    u = rms_norm(h, pre)
    proj = u @ w_in
    q, k, v, z, xbc, dt_raw = jnp.split(
        proj, np.cumsum([SB_WIDTH, SB_WIDTH, SB_WIDTH, SSM_INNER, CONV_DIM]).tolist(), axis=-1)
    heads = lambda t: t.reshape(b, s, SB_HEADS, SB_HEAD_DIM).transpose(0, 2, 1, 3)
    sb = stick_breaking(heads(q), heads(k), heads(v)).transpose(0, 2, 1, 3).reshape(b, s, SB_WIDTH)
    sb = rms_norm(sb, sb_norm)
    xbc = jax.nn.silu(causal_dwconv(xbc, conv_w, conv_b))
    xs, bm, cm = jnp.split(xbc, [SSM_INNER, SSM_INNER + SSM_GROUPS * SSM_STATE], axis=-1)
    xs = xs.reshape(b, s, SSM_HEADS, SSM_HEAD_DIM).astype(jnp.float32)
    bm = bm.reshape(b, s, SSM_GROUPS, SSM_STATE).astype(jnp.float32)
    cm = cm.reshape(b, s, SSM_GROUPS, SSM_STATE).astype(jnp.float32)
    dt = jax.nn.softplus(dt_raw.astype(jnp.float32) + dt_bias.astype(jnp.float32))
    a = -jnp.exp(a_log.astype(jnp.float32))
    y = ssd(xs, dt, a, bm, cm) + d_skip.astype(jnp.float32)[:, None] * xs
    y = y.reshape(b, s, SSM_INNER) * jax.nn.silu(z.astype(jnp.float32))
    y = rms_norm(y, ssm_norm).astype(h.dtype)
    out = jnp.concatenate([sb, y], axis=-1) @ w_out
    return rms_norm(out, post)


def memory_xattn(h, mem, pre, kv_norm, w_mq, w_mkv, w_mo, post):
    b, s, _ = h.shape
    u = rms_norm(h, pre)
    m = rms_norm(mem, kv_norm)
    q = (u @ w_mq).reshape(b, s, MEM_HEADS, MEM_HEAD_DIM)
    k, v = jnp.split((m @ w_mkv).reshape(b, -1, 2, MEM_HEADS, MEM_HEAD_DIM), 2, axis=2)
    k, v = k[:, :, 0], v[:, :, 0]
    scores = jnp.einsum('bshd,bmhd->bhsm', q, k).astype(jnp.float32) * (MEM_HEAD_DIM ** -0.5)
    p = jax.nn.softmax(scores, axis=-1)
    o = jnp.einsum('bhsm,bmhd->bshd', p.astype(v.dtype), v).reshape(b, s, MEM_WIDTH)
    return rms_norm(o @ w_mo, post)


def setup_inputs(seed: int = 0) -> dict:
    key = jax.random.key(seed)
    ks = iter(jax.random.split(key, 40))
    f32 = jnp.float32
    L = DEPTH

    def normal(shape, scale):
        return scale * jax.random.normal(next(ks), shape, f32)

    def gain(dim):
        return 1.0 + 0.05 * jax.random.normal(next(ks), (L, dim), f32)

    def ffn_params():
        return (gain(D_MODEL), normal((L, D_MODEL, D_FF), D_MODEL ** -0.5),
                normal((L, D_MODEL, D_FF), D_MODEL ** -0.5), normal((L, D_FF, D_MODEL), D_FF ** -0.5),
                gain(D_MODEL))

    x = normal((BATCH, SEQ, D_MODEL), 1.0)
    mem = normal((BATCH, N_MEM, D_MODEL), 1.0)
    f1 = ffn_params()
    mix_pre = gain(D_MODEL)
    w_in = normal((L, D_MODEL, IN_PROJ_DIM), D_MODEL ** -0.5)
    conv_w = normal((L, SSM_CONV, CONV_DIM), SSM_CONV ** -0.5)
    conv_b = normal((L, CONV_DIM), 0.01)
    dt0 = jnp.exp(jax.random.uniform(next(ks), (L, SSM_HEADS), f32, np.log(1e-3), np.log(1e-1)))
    dt_bias = dt0 + jnp.log(-jnp.expm1(-dt0))
    a_log = jnp.log(jax.random.uniform(next(ks), (L, SSM_HEADS), f32, 1.0, 16.0))
    d_skip = 1.0 + 0.05 * jax.random.normal(next(ks), (L, SSM_HEADS), f32)
    sb_norm = gain(SB_WIDTH)
    ssm_norm = gain(SSM_INNER)
    w_out = normal((L, MIX_WIDTH, D_MODEL), MIX_WIDTH ** -0.5)
    mix_post = gain(D_MODEL)
    mem_pre = gain(D_MODEL)
    mem_kv_norm = gain(D_MODEL)
    w_mq = normal((L, D_MODEL, MEM_WIDTH), D_MODEL ** -0.5)
    w_mkv = normal((L, D_MODEL, 2 * MEM_WIDTH), D_MODEL ** -0.5)
    w_mo = normal((L, MEM_WIDTH, D_MODEL), MEM_WIDTH ** -0.5)
    mem_post = gain(D_MODEL)
    f2 = ffn_params()
    return {"x": x, "mem": mem,
            "ffn1_pre": f1[0], "ffn1_wg": f1[1], "ffn1_wu": f1[2], "ffn1_wd": f1[3], "ffn1_post": f1[4],
            "mix_pre": mix_pre, "w_in": w_in, "conv_w": conv_w, "conv_b": conv_b, "dt_bias": dt_bias,
            "a_log": a_log, "d_skip": d_skip, "sb_norm": sb_norm, "ssm_norm": ssm_norm, "w_out": w_out,
            "mix_post": mix_post, "mem_pre": mem_pre, "mem_kv_norm": mem_kv_norm, "w_mq": w_mq,
            "w_mkv": w_mkv, "w_mo": w_mo, "mem_post": mem_post,
            "ffn2_pre": f2[0], "ffn2_wg": f2[1], "ffn2_wu": f2[2], "ffn2_wd": f2[3], "ffn2_post": f2[4]}


def reference(x, mem,
              ffn1_pre, ffn1_wg, ffn1_wu, ffn1_wd, ffn1_post,
              mix_pre, w_in, conv_w, conv_b, dt_bias, a_log, d_skip, sb_norm, ssm_norm, w_out, mix_post,
              mem_pre, mem_kv_norm, w_mq, w_mkv, w_mo, mem_post,
              ffn2_pre, ffn2_wg, ffn2_wu, ffn2_wd, ffn2_post):
    h = x
    for l in range(DEPTH):
        h = h + 0.5 * rms_norm(swiglu(rms_norm(h, ffn1_pre[l]), ffn1_wg[l], ffn1_wu[l], ffn1_wd[l]), ffn1_post[l])
        h = h + parallel_mixer(h, mix_pre[l], w_in[l], conv_w[l], conv_b[l], dt_bias[l], a_log[l], d_skip[l],
                               sb_norm[l], ssm_norm[l], w_out[l], mix_post[l])
        h = h + memory_xattn(h, mem, mem_pre[l], mem_kv_norm[l], w_mq[l], w_mkv[l], w_mo[l], mem_post[l])
        h = h + 0.5 * rms_norm(swiglu(rms_norm(h, ffn2_pre[l]), ffn2_wg[l], ffn2_wu[l], ffn2_wd[l]), ffn2_post[l])
    return h
```

```cpp
#include <hip/hip_runtime.h>
#include <hip/hip_cooperative_groups.h>
#include <cstdio>
#include <cstdint>
namespace cg = cooperative_groups;

namespace pg8 {
#define PG8_LAS __attribute__((address_space(3)))
typedef unsigned short bf16_t;
typedef short bf16x8 __attribute__((ext_vector_type(8)));
typedef float f32x4 __attribute__((ext_vector_type(4)));
typedef unsigned u32x4 __attribute__((ext_vector_type(4)));
constexpr int BM = 256, BK = 64, HALF = 128, HTB = HALF * BK * 2  , STAGE_BYTES = 8 * HTB, NXCD = 8, WGM = 8;

__host__ __device__ __forceinline__ int lds_byte(int r, int c) { const int st = (r >> 4) * 2 + (c >> 5), rr = r & 15, cc = c & 31, ob = rr * 64 + cc * 2; return st * 1024 + (ob ^ (((ob >> 9) & 1) << 5)); }
__host__ __device__ __forceinline__ void stage_rc(int b, int& R, int& C) { const int st = b / 1024, sb = b % 1024, swz = sb ^ (((sb >> 9) & 1) << 5); R = (st >> 1) * 16 + swz / 64; C = (st & 1) * 32 + (swz % 64) / 2; }
__host__ __device__ __forceinline__ int perm32(int rho) { const int n = rho >> 4, i = rho & 15; return 8 * (i >> 2) + 4 * n + (i & 3); }

struct Unit { int pm, pn; };
struct Gemm { const bf16_t* A; const bf16_t* Bt; int M, N, K; int lda; int wid = 0; };

struct StaticOrder {
    int nM, nN, nwg, G, c;
    __host__ __device__ void init(int M, int N, int G_, int c_) { nM = M / BM; nN = N / BM; nwg = nM * nN; G = G_; c = c_; }
    __host__ __device__ bool next(int i, Unit& u) const {
        const long L = (long)i * G + c; if (L >= nwg) return false;
        int wgid = (int)L; { const int q = nwg / NXCD, r = nwg % NXCD, xcd = wgid % NXCD, off = wgid / NXCD; wgid = (xcd < r ? xcd * (q + 1) : r * (q + 1) + (xcd - r) * q) + off; }
        const int nig = WGM * nN, gid = wgid / nig, fm = gid * WGM, gsz = (nM - fm) < WGM ? (nM - fm) : WGM;
        u.pm = fm + ((wgid % nig) % gsz); u.pn = (wgid % nig) / gsz; return true;
    }
    __device__ __forceinline__ void a_ready(const Unit&) const {}
    __device__ __forceinline__ void done(const Unit&) const {}
};

typedef __bf16 bf16x2_t __attribute__((ext_vector_type(2)));
typedef float f32x2_t __attribute__((ext_vector_type(2)));
__device__ __forceinline__ unsigned cvt_pk_bf16(float lo, float hi) { f32x2_t v = {lo, hi}; bf16x2_t b = __builtin_convertvector(v, bf16x2_t); return __builtin_bit_cast(unsigned, b); }
__device__ __forceinline__ float silu_f(float x) { return x * __builtin_amdgcn_rcpf(1.0f + __builtin_amdgcn_exp2f(-1.4426950408889634f * x)); }

__device__ __forceinline__ int hw_lane() { unsigned z = 0u; asm volatile("" : "+v"(z)); return (int)__builtin_amdgcn_mbcnt_hi(~0u, __builtin_amdgcn_mbcnt_lo(~0u, z)); }
typedef int v8i32 __attribute__((ext_vector_type(8)));
typedef int v4i32 __attribute__((ext_vector_type(4)));
__device__ __forceinline__ v8i32 cat16(v4i32 lo, v4i32 hi) { return __builtin_shufflevector(lo, hi, 0, 1, 2, 3, 4, 5, 6, 7); }
__device__ __forceinline__ unsigned pk4_fp8(float a, float b, float c, float d) { unsigned w = 0u;
    a = __builtin_amdgcn_fmed3f(a, -448.f, 448.f); b = __builtin_amdgcn_fmed3f(b, -448.f, 448.f); c = __builtin_amdgcn_fmed3f(c, -448.f, 448.f); d = __builtin_amdgcn_fmed3f(d, -448.f, 448.f);
    w = __builtin_amdgcn_cvt_pk_fp8_f32(a, b, w, false); w = __builtin_amdgcn_cvt_pk_fp8_f32(c, d, w, true); return w; }
struct EpiBf16 {
    static constexpr bool PERM = true, AFTER_DRAIN = false;
    bf16_t* O; int ldc; const float* rscale; float cs = 1.0f;
    __device__ __forceinline__ void operator()(const f32x4 (&acc)[2][2][4][2], const Unit& u, int wr, int wc, int fr, int fq) const {
        { int l_ = hw_lane(); asm volatile("" : "+v"(l_)); fr = l_ & 15; fq = l_ >> 4; }
        const int row0 = u.pm * BM + wr * 64 + fr; const int col0 = u.pn * BM + wc * 32 + 8 * fq;
        float rsv[2][4];
#pragma unroll
        for (int ai = 0; ai < 2; ++ai)
#pragma unroll
            for (int m = 0; m < 4; ++m) rsv[ai][m] = (rscale ? rscale[row0 + ai * HALF + m * 16] : 1.0f) * cs;
#pragma unroll
        for (int ai = 0; ai < 2; ++ai)
#pragma unroll
            for (int m = 0; m < 4; ++m) { bf16_t* rowp = O + (size_t)(row0 + ai * HALF + m * 16) * ldc + col0; const float rs = rsv[ai][m];
#pragma unroll
                for (int bj = 0; bj < 2; ++bj) { const f32x4 v0 = acc[ai][bj][m][0] * rs, v1 = acc[ai][bj][m][1] * rs;
                    u32x4 w; w.x = cvt_pk_bf16(v0[0], v0[1]); w.y = cvt_pk_bf16(v0[2], v0[3]); w.z = cvt_pk_bf16(v1[0], v1[1]); w.w = cvt_pk_bf16(v1[2], v1[3]);
                    *(u32x4*)(rowp + bj * HALF) = w; } }
    }
};
struct EpiBf16S {
    static constexpr bool PERM = true, AFTER_DRAIN = false;
    bf16_t* O; int ldc; float cs;
    __device__ __forceinline__ void operator()(const f32x4 (&acc)[2][2][4][2], const Unit& u, int wr, int wc, int fr, int fq) const {
        { int l_ = hw_lane(); asm volatile("" : "+v"(l_)); fr = l_ & 15; fq = (l_ >> 4) & 3; }
        typedef __attribute__((address_space(1))) char gchar;
        gchar* const base = (gchar*)O + ((size_t)(u.pm * BM + wr * 64) * ldc + u.pn * BM + wc * 32) * 2;
        const unsigned lo = (unsigned)(fr * ldc + 8 * fq) * 2u;
#pragma unroll
        for (int ai = 0; ai < 2; ++ai)
#pragma unroll
            for (int m = 0; m < 4; ++m) {
#pragma unroll
                for (int bj = 0; bj < 2; ++bj) { const f32x4 v0 = acc[ai][bj][m][0] * cs, v1 = acc[ai][bj][m][1] * cs;
                    u32x4 w; w.x = cvt_pk_bf16(v0[0], v0[1]); w.y = cvt_pk_bf16(v0[2], v0[3]); w.z = cvt_pk_bf16(v1[0], v1[1]); w.w = cvt_pk_bf16(v1[2], v1[3]);
                    *(__attribute__((address_space(1))) u32x4*)(base + (size_t)((ai * HALF + m * 16) * ldc + bj * HALF) * 2 + lo) = w; } }
    }
};
struct EpiSwiGLU8 {
    static constexpr bool PERM = true, AFTER_DRAIN = false;
    unsigned char* O8; int ldc; float cs;
    __device__ __forceinline__ void operator()(const f32x4 (&acc)[2][2][4][2], const Unit& u, int wr, int wc, int fr, int fq) const {
        { int l_ = hw_lane(); asm volatile("" : "+v"(l_)); fr = l_ & 15; fq = (l_ >> 4) & 3; }
        typedef __attribute__((address_space(1))) char gchar; typedef unsigned u32x2 __attribute__((ext_vector_type(2)));
        gchar* const base = (gchar*)O8 + (size_t)(u.pm * BM + wr * 64) * ldc + u.pn * HALF + wc * 32;
        const unsigned lo = (unsigned)(fr * ldc + 8 * fq);
#pragma unroll
        for (int ai = 0; ai < 2; ++ai)
#pragma unroll
            for (int m = 0; m < 4; ++m) {
                const f32x4 g0 = acc[ai][0][m][0] * cs, g1 = acc[ai][0][m][1] * cs, u0 = acc[ai][1][m][0] * cs, u1 = acc[ai][1][m][1] * cs;
                u32x2 w; w.x = pk4_fp8(silu_f(g0[0]) * u0[0], silu_f(g0[1]) * u0[1], silu_f(g0[2]) * u0[2], silu_f(g0[3]) * u0[3]);
                w.y = pk4_fp8(silu_f(g1[0]) * u1[0], silu_f(g1[1]) * u1[1], silu_f(g1[2]) * u1[2], silu_f(g1[3]) * u1[3]);
                *(__attribute__((address_space(1))) u32x2*)(base + (size_t)((ai * HALF + m * 16) * ldc) + lo) = w; }
    }
};
struct EpiSwiGLU {
    static constexpr bool PERM = true, AFTER_DRAIN = false;
    bf16_t* O; int ldc; const float* rscale;
    __device__ __forceinline__ void operator()(const f32x4 (&acc)[2][2][4][2], const Unit& u, int wr, int wc, int fr, int fq) const {
        const int row0 = u.pm * BM + wr * 64 + fr; const int col0 = u.pn * HALF + wc * 32 + 8 * fq;
        float rsv[2][4];
#pragma unroll
        for (int ai = 0; ai < 2; ++ai)
#pragma unroll
            for (int m = 0; m < 4; ++m) rsv[ai][m] = rscale[row0 + ai * HALF + m * 16];
#pragma unroll
        for (int ai = 0; ai < 2; ++ai)
#pragma unroll
            for (int m = 0; m < 4; ++m) { bf16_t* rowp = O + (size_t)(row0 + ai * HALF + m * 16) * ldc + col0;
                const float rs = rsv[ai][m];
                const f32x4 g0 = acc[ai][0][m][0] * rs, g1 = acc[ai][0][m][1] * rs, u0 = acc[ai][1][m][0] * rs, u1 = acc[ai][1][m][1] * rs;
                u32x4 w; w.x = cvt_pk_bf16(silu_f(g0[0]) * u0[0], silu_f(g0[1]) * u0[1]); w.y = cvt_pk_bf16(silu_f(g0[2]) * u0[2], silu_f(g0[3]) * u0[3]);
                w.z = cvt_pk_bf16(silu_f(g1[0]) * u1[0], silu_f(g1[1]) * u1[1]); w.w = cvt_pk_bf16(silu_f(g1[2]) * u1[2], silu_f(g1[3]) * u1[3]);
                *(u32x4*)rowp = w; }
    }
};

template <class Epi, class Sched, bool ALIGN_EPI = false, bool SP2 = false, bool FP8 = false>
__device__ __forceinline__ void gemm_phase(PG8_LAS unsigned char* lds, const Gemm g, const Sched& S, const Epi& E) {
    int tid_l = g.wid * 64 + hw_lane(); asm volatile("" : "+v"(tid_l));
    const int tid = tid_l, wid = __builtin_amdgcn_readfirstlane(tid >> 6), lane = tid & 63, wr = wid >> 2, wc = wid & 3, fr = lane & 15, fq = lane >> 4;
    const int K = g.K, nt = K / BK;
    unsigned voffA, voffB;
    { int R, C; stage_rc(tid * 16, R, C); const int Rb = Epi::PERM ? ((R & ~31) + perm32(R & 31)) : R;
      voffA = (unsigned)(R * g.lda + C) * 2u; voffB = (unsigned)(Rb * K + C) * 2u; }
    const size_t voffA_r64 = (size_t)64 * g.lda * 2, voffB_r64 = (size_t)64 * K * 2;
    const size_t kstep = (size_t)(BK * 2);
    const size_t hstep = (size_t)HALF * K * 2;
    const size_t tstep = 2 * hstep;
    const size_t hstepA = (size_t)HALF * g.lda * 2, tstepA = 2 * hstepA;
    const unsigned ldsw = (unsigned)wid * 1024u; const unsigned ldsbase_ = (unsigned)(size_t)lds;
    const int aoff = lds_byte(wr * 64 + fr, fq * 8), boff = lds_byte(wc * 32 + fr, fq * 8);
#define PG8_SA(b, h) (((b) * 2 + (h)) * HTB)
#define PG8_SB(b, h) ((4 + (b) * 2 + (h)) * HTB)
#define PG8_STAGE(bufoff, gbase, voff) do { _Pragma("unroll") for (int _i = 0; _i < 2; ++_i) { unsigned keep_; \
        asm volatile("s_mov_b32 %0, m0\n\ts_mov_b32 m0, %3\n\ts_nop 0\n\tglobal_load_lds_dwordx4 %1, %2\n\ts_mov_b32 m0, %0" : "=&s"(keep_) \
            : "v"(voff), "s"((const char*)(gbase) + (size_t)_i * voff##_r64), "s"((unsigned)(ldsbase_ + (bufoff) + ldsw + _i * 8192)) : "memory"); } } while (0)
#define PG8_LDA(dst, b, h) do { if constexpr (FP8) { _Pragma("unroll") for (int m = 0; m < 4; ++m) dst##8[m] = cat16(*(const PG8_LAS v4i32*)(lds + PG8_SA(b, h) + aoff + m * 2048), *(const PG8_LAS v4i32*)(lds + PG8_SA(b, h) + aoff + m * 2048 + 1024)); } \
        else { _Pragma("unroll") for (int m = 0; m < 4; ++m) _Pragma("unroll") for (int k = 0; k < 2; ++k) dst[m][k] = *(const PG8_LAS bf16x8*)(lds + PG8_SA(b, h) + aoff + m * 2048 + k * 1024); } } while (0)
#define PG8_LDB(dst, b, h) do { if constexpr (FP8) { _Pragma("unroll") for (int n = 0; n < 2; ++n) dst##8[n] = cat16(*(const PG8_LAS v4i32*)(lds + PG8_SB(b, h) + boff + n * 2048), *(const PG8_LAS v4i32*)(lds + PG8_SB(b, h) + boff + n * 2048 + 1024)); } \
        else { _Pragma("unroll") for (int n = 0; n < 2; ++n) _Pragma("unroll") for (int k = 0; k < 2; ++k) dst[n][k] = *(const PG8_LAS bf16x8*)(lds + PG8_SB(b, h) + boff + n * 2048 + k * 1024); } } while (0)
#define PG8_MMA(ai, bj, At, Bt) do { __builtin_amdgcn_s_setprio(1); \
        if constexpr (FP8) { _Pragma("unroll") for (int m = 0; m < 4; ++m) _Pragma("unroll") for (int n = 0; n < 2; ++n) \
            acc[ai][bj][m][n] = __builtin_amdgcn_mfma_scale_f32_16x16x128_f8f6f4(Bt##8[n], At##8[m], acc[ai][bj][m][n], 0, 0, 0, 127, 0, 127); } \
        else { _Pragma("unroll") for (int m = 0; m < 4; ++m) _Pragma("unroll") for (int n = 0; n < 2; ++n) _Pragma("unroll") for (int k = 0; k < 2; ++k) \
            acc[ai][bj][m][n] = __builtin_amdgcn_mfma_f32_16x16x32_bf16(Bt[n][k], At[m][k], acc[ai][bj][m][n], 0, 0, 0); } \
        __builtin_amdgcn_s_setprio(0); } while (0)
#define PG8_WAIT_V(n) asm volatile("s_waitcnt vmcnt(" #n ")" ::: "memory")
#define PG8_WAIT_L(n) asm volatile("s_waitcnt lgkmcnt(" #n ")" ::: "memory")
#define PG8_BAR __builtin_amdgcn_s_barrier()
#define PG8_SCHED __builtin_amdgcn_sched_barrier(0)
    Unit cur, nxt; int ui = 0;
    if (!S.next(0, cur)) return;
    f32x4 acc[2][2][4][2];
#pragma unroll
    for (int a = 0; a < 2; ++a)
#pragma unroll
        for (int b = 0; b < 2; ++b)
#pragma unroll
            for (int m = 0; m < 4; ++m)
#pragma unroll
                for (int n = 0; n < 2; ++n) acc[a][b][m][n] = (f32x4){0.f, 0.f, 0.f, 0.f};
    bf16x8 At[4][2], B0[2][2], B1[2][2]; v8i32 At8[4], B08[2], B18[2];
    const char* cA = (const char*)g.A + (size_t)cur.pm * tstepA; const char* cB = (const char*)g.Bt + (size_t)cur.pn * tstep;
    S.a_ready(cur);
    if constexpr (SP2) {
        PG8_STAGE(PG8_SB(0, 0), cB, voffB); PG8_STAGE(PG8_SB(0, 1), cB + hstep, voffB); PG8_STAGE(PG8_SA(0, 0), cA, voffA); PG8_STAGE(PG8_SA(0, 1), cA + hstepA, voffA);
        if (wr == 1) PG8_BAR;
        PG8_WAIT_V(2); PG8_BAR;
        PG8_STAGE(PG8_SB(1, 0), cB + kstep, voffB); PG8_STAGE(PG8_SA(1, 0), cA + kstep, voffA); PG8_STAGE(PG8_SB(1, 1), cB + hstep + kstep, voffB);
        PG8_WAIT_V(6); PG8_BAR;
    } else {
        PG8_STAGE(PG8_SB(0, 0), cB, voffB); PG8_STAGE(PG8_SA(0, 0), cA, voffA); PG8_STAGE(PG8_SB(0, 1), cB + hstep, voffB); PG8_STAGE(PG8_SA(0, 1), cA + hstepA, voffA);
        if (wr == 1) PG8_BAR;
        PG8_WAIT_V(4); PG8_BAR;
        PG8_STAGE(PG8_SB(1, 0), cB + kstep, voffB); PG8_STAGE(PG8_SA(1, 0), cA + kstep, voffA); PG8_STAGE(PG8_SB(1, 1), cB + hstep + kstep, voffB);
        PG8_WAIT_V(6); PG8_BAR;
    }
    for (;;) {
        const bool has_next = S.next(ui + 1, nxt);
        const char* nA = has_next ? (const char*)g.A + (size_t)nxt.pm * tstepA : cA; const char* nB = has_next ? (const char*)g.Bt + (size_t)nxt.pn * tstep : cB;
        for (int t = 0; t < nt; t += 2) {
            const bool last = (t == nt - 2);
            const char* a1 = cA + (size_t)(t + 1) * kstep;
            const char* a2 = last ? nA : cA + (size_t)(t + 2) * kstep; const char* b2 = last ? nB : cB + (size_t)(t + 2) * kstep;
            const char* a3 = a2 + kstep; const char* b3 = b2 + kstep;
            if (last && has_next) S.a_ready(nxt);
            if constexpr (SP2) {
            PG8_LDB(B0, 0, 0); PG8_LDB(B1, 0, 1); PG8_SCHED; PG8_LDA(At, 0, 0); PG8_STAGE(PG8_SA(1, 1), a1 + hstepA, voffA);
            PG8_WAIT_V(8); PG8_WAIT_L(0); PG8_BAR; PG8_MMA(0, 0, At, B0); PG8_MMA(0, 1, At, B1); PG8_BAR; PG8_SCHED;
            PG8_LDA(At, 0, 1); PG8_STAGE(PG8_SB(0, 0), b2, voffB); PG8_STAGE(PG8_SB(0, 1), b2 + hstep, voffB); PG8_STAGE(PG8_SA(0, 0), a2, voffA);
            PG8_WAIT_V(8); PG8_WAIT_L(0); PG8_BAR; PG8_MMA(1, 0, At, B0); PG8_MMA(1, 1, At, B1); PG8_BAR; PG8_SCHED;
            PG8_LDB(B0, 1, 0); PG8_LDB(B1, 1, 1); PG8_SCHED; PG8_LDA(At, 1, 0); PG8_STAGE(PG8_SA(0, 1), a2 + hstepA, voffA);
            PG8_WAIT_V(8); PG8_WAIT_L(0); PG8_BAR; PG8_MMA(0, 0, At, B0); PG8_MMA(0, 1, At, B1); PG8_BAR; PG8_SCHED;
            PG8_LDA(At, 1, 1); PG8_STAGE(PG8_SB(1, 0), b3, voffB); PG8_STAGE(PG8_SB(1, 1), b3 + hstep, voffB); PG8_STAGE(PG8_SA(1, 0), a3, voffA);
            PG8_WAIT_V(8); PG8_WAIT_L(0); PG8_BAR; PG8_MMA(1, 0, At, B0); PG8_MMA(1, 1, At, B1); PG8_BAR; PG8_SCHED;
            } else {
            PG8_LDB(B0, 0, 0); PG8_SCHED; PG8_LDA(At, 0, 0); PG8_STAGE(PG8_SA(1, 1), a1 + hstepA, voffA);
            PG8_WAIT_L(8); PG8_BAR; PG8_WAIT_L(0); PG8_MMA(0, 0, At, B0); PG8_BAR; PG8_SCHED;
            PG8_LDB(B1, 0, 1); PG8_STAGE(PG8_SB(0, 0), b2, voffB);
            PG8_BAR; PG8_WAIT_L(0); PG8_MMA(0, 1, At, B1); PG8_BAR;
            PG8_LDA(At, 0, 1); PG8_STAGE(PG8_SA(0, 0), a2, voffA);
            PG8_BAR; PG8_WAIT_L(0); PG8_MMA(1, 0, At, B0); PG8_BAR; PG8_SCHED;
            PG8_STAGE(PG8_SB(0, 1), b2 + hstep, voffB);
            PG8_WAIT_V(6); PG8_BAR; PG8_MMA(1, 1, At, B1); PG8_BAR;
            PG8_LDB(B0, 1, 0); PG8_SCHED; PG8_LDA(At, 1, 0); PG8_STAGE(PG8_SA(0, 1), a2 + hstepA, voffA);
            PG8_WAIT_L(8); PG8_BAR; PG8_WAIT_L(0); PG8_MMA(0, 0, At, B0); PG8_BAR; PG8_SCHED;
            PG8_LDB(B1, 1, 1); PG8_STAGE(PG8_SB(1, 0), b3, voffB);
            PG8_BAR; PG8_WAIT_L(0); PG8_MMA(0, 1, At, B1); PG8_BAR;
            PG8_LDA(At, 1, 1); PG8_STAGE(PG8_SA(1, 0), a3, voffA);
            PG8_BAR; PG8_WAIT_L(0); PG8_MMA(1, 0, At, B0); PG8_BAR; PG8_SCHED;
            PG8_STAGE(PG8_SB(1, 1), b3 + hstep, voffB);
            PG8_WAIT_V(6); PG8_BAR; PG8_MMA(1, 1, At, B1); PG8_BAR;
            }
        }
        if constexpr (ALIGN_EPI) { if (wr == 0) PG8_BAR; }
        if constexpr (!Epi::AFTER_DRAIN) { E(acc, cur, wr, wc, fr, fq); S.done(cur); }
        if (!has_next) break;
#pragma unroll
        for (int a = 0; a < 2; ++a)
#pragma unroll
            for (int b = 0; b < 2; ++b)
#pragma unroll
                for (int m = 0; m < 4; ++m)
#pragma unroll
                    for (int n = 0; n < 2; ++n) acc[a][b][m][n] = (f32x4){0.f, 0.f, 0.f, 0.f};
        cur = nxt; cA = nA; cB = nB; ++ui;
        if constexpr (ALIGN_EPI) { if (wr == 1) PG8_BAR; }
    }
    PG8_WAIT_V(0);
    if constexpr (!ALIGN_EPI) { if (wr == 0) PG8_BAR; }
    PG8_BAR;
    if constexpr (Epi::AFTER_DRAIN) { E.fused(acc, cur, wr, wc, fr, fq, lds, wid, lane); S.done(cur); }
#undef PG8_SA
#undef PG8_SB
#undef PG8_STAGE
#undef PG8_LDA
#undef PG8_LDB
#undef PG8_MMA
#undef PG8_WAIT_V
#undef PG8_WAIT_L
#undef PG8_BAR
#undef PG8_SCHED
}
}
constexpr int NWAVES = 8;
constexpr int BATCH = 8, SEQ = 2048, D = 2048, T = BATCH * SEQ, FF = 5504, NMEM = 256;
constexpr int INP = 6160, PROJ_LD = 6144, INP_PAD = 6400;
constexpr int QOFF = 0, KOFF = 1024, VOFF = 2048, ZOFF = 3072, XBCOFF = 4096;
constexpr int MEMW = 512;
constexpr int ACT8_LD = 5632;
constexpr float W2GU_SCALE = 32.0f;
constexpr float W2D_SCALE = 64.0f;
constexpr float EPS = 1e-6f;
constexpr size_t MiB = 1u << 20;
constexpr size_t WS_W1GU = 0, WS_W1D = 43 * MiB, WS_W2GU = WS_W1D + 43 * MiB / 2, WS_W2D = WS_W2GU + 43 * MiB, WS_WIN = 129 * MiB, WS_WOUT = 154 * MiB,
                 WS_WMQ = 162 * MiB, WS_WMKV = 164 * MiB, WS_WMO = 168 * MiB, WS_MN = 170 * MiB, WS_KVM = 178 * MiB, WS_DT = 182 * MiB,
                 WS_U = 184 * MiB, WS_Y = 248 * MiB, WS_BIG = 312 * MiB, WS_END = 504 * MiB;
static_assert(WS_W2D + 43 * MiB / 2 == WS_WIN, "ws map");
constexpr size_t WS_CTL = WS_END, CTL_BYTES = 16384;
constexpr size_t WS_WL = WS_END + 65536, WS_EL = WS_WL + MiB, WS_TOP = WS_EL + MiB;
constexpr size_t WS_RS = WS_TOP, WS_TOP2 = WS_RS + 65536;
constexpr size_t WS_QM = WS_BIG, WS_OM = WS_BIG + 16 * MiB;
constexpr int LDS_BYTES = 131072 + 1024;

#define GAS __attribute__((address_space(1)))
#define LAS __attribute__((address_space(3)))
typedef unsigned short bf16;
typedef unsigned v4u __attribute__((ext_vector_type(4)));
typedef unsigned v2u __attribute__((ext_vector_type(2)));
typedef float f32x4 __attribute__((ext_vector_type(4)));
typedef float f32x16 __attribute__((ext_vector_type(16)));
typedef short bf16x8 __attribute__((ext_vector_type(8)));
typedef short s16x4 __attribute__((ext_vector_type(4)));
typedef short v4i16_t __attribute__((ext_vector_type(4)));
#define LDS_WAIT() asm volatile("s_waitcnt lgkmcnt(0)" ::: "memory")
#define CFENCE() asm volatile("" ::: "memory")
__device__ __forceinline__ unsigned f2bf(float f) { unsigned u = __builtin_bit_cast(unsigned, f); return (u + 0x7fffu + ((u >> 16) & 1u)) >> 16; }
typedef __bf16 bf16x2_t __attribute__((ext_vector_type(2)));
typedef float f32x2_t __attribute__((ext_vector_type(2)));
__device__ __forceinline__ unsigned pk2(float lo, float hi) { f32x2_t v = {lo, hi}; bf16x2_t b = __builtin_convertvector(v, bf16x2_t); return __builtin_bit_cast(unsigned, b); }
__device__ __forceinline__ float bflo(unsigned w) { return __builtin_bit_cast(float, w << 16); }
__device__ __forceinline__ float bfhi(unsigned w) { return __builtin_bit_cast(float, w & 0xffff0000u); }
__device__ __forceinline__ float fexp(float x) { return __builtin_amdgcn_exp2f(1.4426950408889634f * x); }
__device__ __forceinline__ float flog(float x) { return 0.6931471805599453f * __builtin_amdgcn_logf(x); }
__device__ __forceinline__ float silu(float x) { return x * __builtin_amdgcn_rcpf(1.0f + fexp(-x)); }
__device__ __forceinline__ float softplus_f(float x) { return fmaxf(x, 0.f) + flog(1.0f + fexp(-fabsf(x))); }
__device__ __forceinline__ s16x4 vtr(const LAS unsigned char* p) { return __builtin_bit_cast(s16x4, __builtin_amdgcn_ds_read_tr16_b64_v4i16((LAS v4i16_t*)p)); }
__device__ __forceinline__ bf16x8 cat8(s16x4 a, s16x4 b) { bf16x8 r; r[0] = a[0]; r[1] = a[1]; r[2] = a[2]; r[3] = a[3]; r[4] = b[0]; r[5] = b[1]; r[6] = b[2]; r[7] = b[3]; return r; }
__device__ __forceinline__ float wave_sum(float v) {
#pragma unroll
    for (int o = 1; o < 64; o <<= 1) v += __shfl_xor(v, o);
    return v;
}

__device__ __forceinline__ float wave_sum_l(float v, int lane) {
#pragma unroll
    for (int o = 1; o < 64; o <<= 1) v += __builtin_bit_cast(float, __builtin_amdgcn_ds_bpermute((lane ^ o) << 2, __builtin_bit_cast(int, v)));
    return v;
}
__device__ __forceinline__ void transpose_item(const float* __restrict__ W, int ldw, int K, bf16* WT, int k0, int n0, int drow0, LAS float* scr, int lane, const float* kg) {
    float v[32];
#pragma unroll
    for (int i = 0; i < 32; ++i) v[i] = W[(size_t)(k0 + 2 * i + (lane >> 5)) * ldw + n0 + (lane & 31)];
    const int c = lane & 7;
    f32x4 ga = {1.f, 1.f, 1.f, 1.f}, gb = ga;
    if (kg) { ga = *(const f32x4*)(kg + k0 + 8 * c); gb = *(const f32x4*)(kg + k0 + 8 * c + 4); }
#pragma unroll
    for (int i = 0; i < 32; ++i) scr[(2 * i + (lane >> 5)) * 33 + (lane & 31)] = v[i];
    LDS_WAIT();
#pragma unroll
    for (int j = 0; j < 4; ++j) { const int n = (lane >> 3) + 8 * j; const LAS float* s = scr + (8 * c) * 33 + n;
        v4u o; o.x = pk2(s[0 * 33] * ga.x, s[1 * 33] * ga.y); o.y = pk2(s[2 * 33] * ga.z, s[3 * 33] * ga.w); o.z = pk2(s[4 * 33] * gb.x, s[5 * 33] * gb.y); o.w = pk2(s[6 * 33] * gb.z, s[7 * 33] * gb.w);
        *(v4u*)(WT + (size_t)(drow0 + n) * K + k0 + 8 * c) = o; }
    LDS_WAIT();
}
__device__ __forceinline__ void transpose_item8(const float* __restrict__ W, int ldw, int ldt, unsigned char* WT, int k0, int n0, int drow0, LAS float* scr, int lane, float sc, const float* kg = nullptr) {
    float v[32];
#pragma unroll
    for (int i = 0; i < 32; ++i) v[i] = W[(size_t)(k0 + 2 * i + (lane >> 5)) * ldw + n0 + (lane & 31)];
    const int c = lane & 7;
    f32x4 ga = {sc, sc, sc, sc}, gb = ga;
    if (kg) { ga = ga * *(const f32x4*)(kg + k0 + 8 * c); gb = gb * *(const f32x4*)(kg + k0 + 8 * c + 4); }
#pragma unroll
    for (int i = 0; i < 32; ++i) scr[(2 * i + (lane >> 5)) * 33 + (lane & 31)] = v[i];
    LDS_WAIT();
#pragma unroll
    for (int j = 0; j < 4; ++j) { const int n = (lane >> 3) + 8 * j; const LAS float* s = scr + (8 * c) * 33 + n;
        v2u o; o.x = pg8::pk4_fp8(s[0 * 33] * ga.x, s[1 * 33] * ga.y, s[2 * 33] * ga.z, s[3 * 33] * ga.w); o.y = pg8::pk4_fp8(s[4 * 33] * gb.x, s[5 * 33] * gb.y, s[6 * 33] * gb.z, s[7 * 33] * gb.w);
        *(v2u*)(WT + (size_t)(drow0 + n) * ldt + k0 + 8 * c) = o; }
    LDS_WAIT();
}
__device__ __forceinline__ void tr_plain(int r, const float* W, int ldw, int K, int nblk, bf16* WT, LAS float* scr, int lane, const float* kg = nullptr) {
    const int kb = r / nblk, nb = r % nblk; transpose_item(W, ldw, K, WT, 64 * kb, 32 * nb, 32 * nb, scr, lane, kg);
}
__device__ __forceinline__ void tr_gu(int r, const float* W, bf16* WT, int up, LAS float* scr, int lane, const float* kg) {
    const int nblk = FF / 32, kb = r / nblk, nb = r % nblk, n0 = 32 * nb; transpose_item(W, FF, D, WT, 64 * kb, n0, 256 * (n0 >> 7) + (n0 & 127) + 128 * up, scr, lane, kg);
}
__device__ __forceinline__ void rms_row_to_bf16(const float* xrow, const float* gain, bf16* orow, int lane) {
    const f32x4* xr = (const f32x4*)xrow + lane; const f32x4* gr = (const f32x4*)gain + lane;
    f32x4 v[8]; float s = 0.f;
#pragma unroll
    for (int j = 0; j < 8; ++j) { v[j] = xr[64 * j]; s += (v[j].x * v[j].x + v[j].y * v[j].y) + (v[j].z * v[j].z + v[j].w * v[j].w); }
    const float rstd = __builtin_amdgcn_rsqf(wave_sum(s) * (1.f / D) + EPS);
    v2u* o8 = (v2u*)orow + lane;
#pragma unroll
    for (int j = 0; j < 8; ++j) { const f32x4 g = gr[64 * j]; v2u w; w.x = pk2(v[j].x * rstd * g.x, v[j].y * rstd * g.y); w.y = pk2(v[j].z * rstd * g.z, v[j].w * rstd * g.w); o8[64 * j] = w; }
}

struct Args { const float* in[29]; float* out; unsigned char* ws; };

__device__ __forceinline__ void p0_prologue(const Args& A, LAS unsigned char* lds, int gw, int NGW, int wave, int lane) {
    LAS float* scr = (LAS float*)(lds + wave * 8704);
    unsigned char* ws = A.ws;
    constexpr int I_GU = (D / 64) * (FF / 32), I_DN = (FF / 64) * (D / 32), I_IN = (D / 64) * (PROJ_LD / 32), I_INT = 256, I_OUT = (D / 64) * (D / 32),
                  I_MQ = (D / 64) * (MEMW / 32), I_MKV = (D / 64) * (2 * MEMW / 32), I_MO = (MEMW / 64) * (D / 32);
    constexpr int NITEMS = 2 * I_GU + I_DN + I_IN + I_INT + I_OUT + I_MQ + I_MKV + I_MO;
    for (int it = gw; it < NITEMS; it += NGW) {
        int r = it;
        if (r < I_GU) { tr_gu(r, A.in[3], (bf16*)(ws + WS_W1GU), 0, scr, lane, A.in[2]); continue; } r -= I_GU;
        if (r < I_GU) { tr_gu(r, A.in[4], (bf16*)(ws + WS_W1GU), 1, scr, lane, A.in[2]); continue; } r -= I_GU;
        if (r < I_DN) { tr_plain(r, A.in[5], D, FF, D / 32, (bf16*)(ws + WS_W1D), scr, lane); continue; } r -= I_DN;
        if (r < I_IN) { tr_plain(r, A.in[8], INP, D, PROJ_LD / 32, (bf16*)(ws + WS_WIN), scr, lane, A.in[7]); continue; } r -= I_IN;
        if (r < I_INT) {
            bf16* dst = (bf16*)(ws + WS_WIN) + (size_t)(PROJ_LD + r) * D + lane * 32; const float* W = A.in[8];
#pragma unroll
            for (int q = 0; q < 4; ++q) { v4u o = {0u, 0u, 0u, 0u};
                if (r < 16) { float f[8];
#pragma unroll
                    for (int e = 0; e < 8; ++e) f[e] = A.in[7][lane * 32 + q * 8 + e] * W[(size_t)(lane * 32 + q * 8 + e) * INP + PROJ_LD + r];
                    o.x = pk2(f[0], f[1]); o.y = pk2(f[2], f[3]); o.z = pk2(f[4], f[5]); o.w = pk2(f[6], f[7]); }
                *(v4u*)(dst + q * 8) = o; }
            continue; } r -= I_INT;
        if (r < I_OUT) { tr_plain(r, A.in[16], D, D, D / 32, (bf16*)(ws + WS_WOUT), scr, lane); continue; } r -= I_OUT;
        if (r < I_MQ) { tr_plain(r, A.in[20], MEMW, D, MEMW / 32, (bf16*)(ws + WS_WMQ), scr, lane, A.in[18]); continue; } r -= I_MQ;
        if (r < I_MKV) { tr_plain(r, A.in[21], 2 * MEMW, D, 2 * MEMW / 32, (bf16*)(ws + WS_WMKV), scr, lane); continue; } r -= I_MKV;
        tr_plain(r, A.in[22], D, MEMW, D / 32, (bf16*)(ws + WS_WMO), scr, lane);
    }
    for (int m = gw; m < T; m += NGW) {
        const f32x4* xr = (const f32x4*)(A.in[0] + (size_t)m * D) + lane; v2u* o8 = (v2u*)((bf16*)(ws + WS_U) + (size_t)m * D) + lane; float ss = 0.f;
#pragma unroll
        for (int j = 0; j < 8; ++j) { const f32x4 v = xr[64 * j]; ss += (v.x * v.x + v.y * v.y) + (v.z * v.z + v.w * v.w); v2u w; w.x = pk2(v.x, v.y); w.y = pk2(v.z, v.w); o8[64 * j] = w; }
        ss = wave_sum(ss); if (lane == 0) ((float*)(ws + WS_RS))[m] = __builtin_amdgcn_rsqf(ss * (1.f / D) + EPS); }
    for (int m = gw; m < BATCH * NMEM; m += NGW) rms_row_to_bf16(A.in[1] + (size_t)m * D, A.in[19], (bf16*)(ws + WS_MN) + (size_t)m * D, lane);
}

__device__ __forceinline__ void ffn2_weights(const Args& A, LAS unsigned char* lds, int gw2, int NGW2, int wave, int lane) {
    LAS float* scr = (LAS float*)(lds + wave * 8704);
    unsigned char* ws = A.ws;
    constexpr int I_GU = (D / 64) * (FF / 32), I_DN = (FF / 64) * (D / 32);
    for (int it = gw2; it < 2 * I_GU + I_DN; it += NGW2) {
        int r = it;
        if (r < 2 * I_GU) { const int up = r >= I_GU ? 1 : 0, rr = r - up * I_GU, nblk = FF / 32, kb = rr / nblk, nb = rr % nblk, n0 = 32 * nb;
            transpose_item8(A.in[25 + up], FF, D, ws + WS_W2GU, 64 * kb, n0, 256 * (n0 >> 7) + (n0 & 127) + 128 * up, scr, lane, W2GU_SCALE, A.in[24]); continue; } r -= 2 * I_GU;
        { const int kb = r / (D / 32), nb = r % (D / 32); transpose_item8(A.in[27], D, ACT8_LD, ws + WS_W2D, 64 * kb, 32 * nb, 32 * nb, scr, lane, W2D_SCALE); }
    }
    for (int i = gw2 * 64 + lane; i < D * 8; i += NGW2 * 64) *(v4u*)(ws + WS_W2D + (size_t)(i >> 3) * ACT8_LD + FF + (i & 7) * 16) = (v4u){0u, 0u, 0u, 0u};
}
template <bool NEXT, bool IN_F32, bool OUT_F32, bool OUT8 = false>
__device__ __forceinline__ void norm_phase(const bf16* Y, const float* xin, const bf16* Hin, bf16* Hout, float* out, const float* gpost, float coef, float* RS, int gw, int NGW, int lane, unsigned char* H8 = nullptr) {
    for (int m = gw; m < T; m += NGW) {
        const v2u* yr = (const v2u*)(Y + (size_t)m * D) + lane;
        f32x4 y[8], h[8]; float s = 0.f;
#pragma unroll
        for (int j = 0; j < 8; ++j) { const v2u w = yr[64 * j];
            if (IN_F32) h[j] = ((const f32x4*)(xin + (size_t)m * D))[64 * j + lane];
            else { const v2u hw = ((const v2u*)(Hin + (size_t)m * D))[64 * j + lane]; h[j] = (f32x4){bflo(hw.x), bfhi(hw.x), bflo(hw.y), bfhi(hw.y)}; }
            y[j] = (f32x4){bflo(w.x), bfhi(w.x), bflo(w.y), bfhi(w.y)};
            s += (y[j].x * y[j].x + y[j].y * y[j].y) + (y[j].z * y[j].z + y[j].w * y[j].w); }
        const float rs = coef * __builtin_amdgcn_rsqf(wave_sum_l(s, lane) * (1.f / D) + EPS);
        float s2 = 0.f;
#pragma unroll
        for (int j = 0; j < 8; ++j) { const f32x4 g = ((const f32x4*)gpost)[64 * j + lane]; h[j] = h[j] + y[j] * rs * g;
            s2 += (h[j].x * h[j].x + h[j].y * h[j].y) + (h[j].z * h[j].z + h[j].w * h[j].w); }
        asm volatile("" ::: "memory");
#pragma unroll
        for (int j = 0; j < 8; ++j) {
            if (OUT_F32) ((f32x4*)(out + (size_t)m * D))[64 * j + lane] = h[j];
            else { v2u hw; hw.x = pk2(h[j].x, h[j].y); hw.y = pk2(h[j].z, h[j].w); ((v2u*)(Hout + (size_t)m * D))[64 * j + lane] = hw; }
            }
        if (NEXT) { const float r2 = __builtin_amdgcn_rsqf(wave_sum_l(s2, lane) * (1.f / D) + EPS); if (lane == 0) RS[m] = r2;
            if (OUT8) {
#pragma unroll
                for (int j = 0; j < 8; ++j) ((unsigned*)(H8 + (size_t)m * D))[64 * j + lane] = pg8::pk4_fp8(h[j].x * r2, h[j].y * r2, h[j].z * r2, h[j].w * r2); } }
    }
}
__device__ __forceinline__ void mixnorm_phase(bf16* MIX, const bf16* PROJ, const float* gsb, const float* gssm, int gw, int NGW, int lane) {
    for (int pr = gw; pr < T / 2; pr += NGW) {
        float v[2][4][8]; float ssb[2] = {0.f, 0.f}, sy[2] = {0.f, 0.f};
#pragma unroll
        for (int r = 0; r < 2; ++r) { const int m = 2 * pr + r;
            const v4u* zr = (const v4u*)(PROJ + (size_t)m * PROJ_LD + ZOFF) + lane;
#pragma unroll
            for (int j = 0; j < 4; ++j) { v4u w;
                if (j < 2) w = ((const v4u*)(MIX + (size_t)m * D))[64 * j + lane];
                else { const int off = 8 * (64 * (j - 2) + lane), hh = off >> 6, ph = (off >> 5) & 1, p0 = off & 31;
                       w = *(const v4u*)(MIX + (size_t)(2 * pr + ph) * D + 1024 + hh * 64 + r * 32 + p0); }
                v[r][j][0] = bflo(w.x); v[r][j][1] = bfhi(w.x); v[r][j][2] = bflo(w.y); v[r][j][3] = bfhi(w.y); v[r][j][4] = bflo(w.z); v[r][j][5] = bfhi(w.z); v[r][j][6] = bflo(w.w); v[r][j][7] = bfhi(w.w);
                if (j >= 2) { const v4u z = zr[64 * (j - 2)]; float zf[8] = {bflo(z.x), bfhi(z.x), bflo(z.y), bfhi(z.y), bflo(z.z), bfhi(z.z), bflo(z.w), bfhi(z.w)};
#pragma unroll
                    for (int e = 0; e < 8; ++e) { v[r][j][e] *= silu(zf[e]); sy[r] += v[r][j][e] * v[r][j][e]; } }
                else {
#pragma unroll
                    for (int e = 0; e < 8; ++e) ssb[r] += v[r][j][e] * v[r][j][e]; } } }
        asm volatile("" ::: "memory");
#pragma unroll
        for (int r = 0; r < 2; ++r) { const int m = 2 * pr + r;
            const float rsb = __builtin_amdgcn_rsqf(wave_sum(ssb[r]) * (1.f / 1024.f) + EPS), ry = __builtin_amdgcn_rsqf(wave_sum(sy[r]) * (1.f / 1024.f) + EPS);
            v4u* mr = (v4u*)(MIX + (size_t)m * D) + lane;
#pragma unroll
            for (int j = 0; j < 4; ++j) { const float* g = (j < 2 ? gsb : gssm) + 8 * (64 * (j & 1) + lane); const f32x4 g0 = *(const f32x4*)g, g1 = *(const f32x4*)(g + 4); const float rr = j < 2 ? rsb : ry;
                v4u w; w.x = pk2(v[r][j][0] * rr * g0.x, v[r][j][1] * rr * g0.y); w.y = pk2(v[r][j][2] * rr * g0.z, v[r][j][3] * rr * g0.w); w.z = pk2(v[r][j][4] * rr * g1.x, v[r][j][5] * rr * g1.y); w.w = pk2(v[r][j][6] * rr * g1.z, v[r][j][7] * rr * g1.w);
                mr[64 * j] = w; } }
    }
}
__device__ __forceinline__ void conv_phase(const bf16* PROJ, const float* cw, const float* cb, bf16* XBC, int gw, int NGW, int lane) {
    for (int it = gw; it < (T / 32) * 4; it += NGW) {
        const int rb = it >> 2, c0 = ((it & 3) * 64 + lane) * 8, t0 = rb * 32;
        float w[4][8], bias[8];
#pragma unroll
        for (int k = 0; k < 4; ++k) { const f32x4 a = *(const f32x4*)(cw + k * 2048 + c0), b = *(const f32x4*)(cw + k * 2048 + c0 + 4); w[k][0] = a.x; w[k][1] = a.y; w[k][2] = a.z; w[k][3] = a.w; w[k][4] = b.x; w[k][5] = b.y; w[k][6] = b.z; w[k][7] = b.w; }
        { const f32x4 a = *(const f32x4*)(cb + c0), b = *(const f32x4*)(cb + c0 + 4); bias[0] = a.x; bias[1] = a.y; bias[2] = a.z; bias[3] = a.w; bias[4] = b.x; bias[5] = b.y; bias[6] = b.z; bias[7] = b.w; }
        const bf16* src = PROJ + (size_t)t0 * PROJ_LD + XBCOFF + c0;
        v4u r0 = {0u, 0u, 0u, 0u}, r1 = r0, r2 = r0;
        if ((t0 & (SEQ - 1)) != 0) { r0 = *(const v4u*)(src - 3 * PROJ_LD); r1 = *(const v4u*)(src - 2 * PROJ_LD); r2 = *(const v4u*)(src - PROJ_LD); }
#pragma unroll 4
        for (int i = 0; i < 32; ++i) {
            const v4u r3 = *(const v4u*)(src + (size_t)i * PROJ_LD);
            float o[8];
#pragma unroll
            for (int e = 0; e < 8; ++e) { const unsigned a0 = r0[e >> 1], a1 = r1[e >> 1], a2 = r2[e >> 1], a3 = r3[e >> 1];
                const float x0 = (e & 1) ? bfhi(a0) : bflo(a0), x1 = (e & 1) ? bfhi(a1) : bflo(a1), x2 = (e & 1) ? bfhi(a2) : bflo(a2), x3 = (e & 1) ? bfhi(a3) : bflo(a3);
                o[e] = silu(bias[e] + w[0][e] * x0 + w[1][e] * x1 + w[2][e] * x2 + w[3][e] * x3); }
            v4u ow; ow.x = pk2(o[0], o[1]); ow.y = pk2(o[2], o[3]); ow.z = pk2(o[4], o[5]); ow.w = pk2(o[6], o[7]);
            *(v4u*)(XBC + (size_t)(t0 + i) * 2048 + c0) = ow;
            r0 = r1; r1 = r2; r2 = r3;
        }
    }
}
__device__ __forceinline__ void dt_phase(const bf16* Ub, int ldu, const float* RS, const bf16* Wdt, float* DT, int gw, int NGW, int lane) {
    const int fr = lane & 15, fq = lane >> 4;
    for (int task = gw; task < T / 16; task += NGW) {
        const bf16* ap = Ub + (size_t)(task * 16 + fr) * ldu + fq * 8; const bf16* bp = Wdt + (size_t)fr * D + fq * 8;
        f32x4 acc0 = {0.f, 0.f, 0.f, 0.f}, acc1 = {0.f, 0.f, 0.f, 0.f};
#pragma unroll 4
        for (int ks = 0; ks < 64; ks += 2) {
            const bf16x8 a0 = *(const bf16x8*)(ap + ks * 32), b0 = *(const bf16x8*)(bp + ks * 32), a1 = *(const bf16x8*)(ap + ks * 32 + 32), b1 = *(const bf16x8*)(bp + ks * 32 + 32);
            acc0 = __builtin_amdgcn_mfma_f32_16x16x32_bf16(a0, b0, acc0, 0, 0, 0); acc1 = __builtin_amdgcn_mfma_f32_16x16x32_bf16(a1, b1, acc1, 0, 0, 0); }
        const f32x4 acc = acc0 + acc1;
#pragma unroll
        for (int r = 0; r < 4; ++r) DT[(size_t)(task * 16 + 4 * fq + r) * 16 + fr] = acc[r] * RS[task * 16 + 4 * fq + r];
    }
}
constexpr int VIMG_LD = 256, VIMG_BYTES = 32 * VIMG_LD;
template <int MODE>
__device__ __forceinline__ void attn_unit(const bf16* Qp, int ldq, const bf16* Kp, const bf16* Vp, int ldkv, int q0, int kt_start, bf16* Op, int ldo, LAS unsigned char* vimg, int lane) {
    asm volatile("" : "+v"(lane));
    const int n = lane & 31, kg = lane >> 5;
    bf16x8 qf[8], kf[8];
    { const bf16* qr = Qp + (size_t)(q0 + n) * ldq + kg * 8;
#pragma unroll
      for (int ks = 0; ks < 8; ++ks) qf[ks] = *(const bf16x8*)(qr + ks * 16); }
    { const bf16* kr = Kp + (size_t)(kt_start * 32 + n) * ldkv + kg * 8;
#pragma unroll
      for (int ks = 0; ks < 8; ++ks) kf[ks] = *(const bf16x8*)(kr + ks * 16); }
    f32x16 o[4];
#pragma unroll
    for (int d = 0; d < 4; ++d)
#pragma unroll
        for (int e = 0; e < 16; ++e) o[d][e] = 0.f;
    float R = 1.f, mrun = -1e30f, lrun = 0.f;
    const float scale = 0.08838834764831845f;
    const int gi = lane & 15, G = lane >> 4;
    const int vq = gi >> 2;
    const LAS unsigned char* vtb = vimg + (4 * (G >> 1) + vq) * VIMG_LD + (2 * (G & 1) + ((gi & 3) >> 1)) * 16 + 8 * (gi & 1);
    for (int kt = kt_start; kt >= 0; --kt) {
        { const bf16* vsrc = Vp + (size_t)(kt * 32 + (lane >> 4)) * ldkv + (((lane & 15) ^ (((lane >> 4) & 3) << 2)) * 8);
#pragma unroll
          for (int k = 0; k < 8; ++k) __builtin_amdgcn_global_load_lds((const unsigned*)(vsrc + (size_t)(4 * k) * ldkv), (LAS unsigned*)(vimg + k * 1024), 16, 0, 0); }
        f32x16 s;
#pragma unroll
        for (int e = 0; e < 16; ++e) s[e] = 0.f;
#pragma unroll
        for (int ks = 0; ks < 8; ++ks) s = __builtin_amdgcn_mfma_f32_32x32x16_bf16(kf[ks], qf[ks], s, 0, 0, 0);
        float p[16];
        if (MODE == 0) {
            const int t = q0 + n, kb = kt * 32 + 4 * kg; const bool diag = (kt * 32 + 31 >= q0);
            float kp[16], g[4];
#pragma unroll
            for (int i = 0; i < 4; ++i) { g[i] = 1.f;
#pragma unroll
                for (int j = 0; j < 4; ++j) { const int e = 4 * i + j; const bool valid = !diag || (kb + 8 * i + j < t);
                    const float r = __builtin_amdgcn_rcpf(1.0f + fexp(s[e] * scale));
                    kp[e] = valid ? r : 1.f; p[e] = valid ? 1.0f - r : 0.f; g[i] *= kp[e]; } }
            float og[4];
#pragma unroll
            for (int i = 0; i < 4; ++i) og[i] = __shfl_xor(g[i], 32);
            float carry = R;
#pragma unroll
            for (int i = 3; i >= 0; --i) {
                float c = carry * (kg == 0 ? og[i] : 1.f);
#pragma unroll
                for (int j = 3; j >= 0; --j) { const int e = 4 * i + j; p[e] *= c; c *= kp[e]; }
                carry *= g[i] * og[i];
            }
            R = carry;
        } else {
            float tm = -1e30f;
#pragma unroll
            for (int e = 0; e < 16; ++e) { s[e] *= scale; tm = fmaxf(tm, s[e]); }
            tm = fmaxf(tm, __shfl_xor(tm, 32));
            const float mn = fmaxf(mrun, tm), alpha = fexp(mrun - mn); mrun = mn; float ls = 0.f;
#pragma unroll
            for (int e = 0; e < 16; ++e) { p[e] = fexp(s[e] - mn); ls += p[e]; }
            lrun = lrun * alpha + ls;
#pragma unroll
            for (int d = 0; d < 4; ++d)
#pragma unroll
                for (int e = 0; e < 16; ++e) o[d][e] *= alpha;
        }
        bf16x8 pb[2];
#pragma unroll
        for (int tt = 0; tt < 2; ++tt) { v4u w; w.x = pk2(p[8 * tt + 0], p[8 * tt + 1]); w.y = pk2(p[8 * tt + 2], p[8 * tt + 3]); w.z = pk2(p[8 * tt + 4], p[8 * tt + 5]); w.w = pk2(p[8 * tt + 6], p[8 * tt + 7]);
            pb[tt] = __builtin_bit_cast(bf16x8, w); }
        asm volatile("s_waitcnt vmcnt(0)" ::: "memory");
        if (kt > 0) { const bf16* kr = Kp + (size_t)((kt - 1) * 32 + n) * ldkv + kg * 8;
#pragma unroll
            for (int ks = 0; ks < 8; ++ks) kf[ks] = *(const bf16x8*)(kr + ks * 16); }
#pragma unroll
        for (int d = 0; d < 4; ++d)
#pragma unroll
            for (int tt = 0; tt < 2; ++tt) {
                const s16x4 a0 = vtr(vtb + (16 * tt) * VIMG_LD + ((d ^ vq) * 64)), a1 = vtr(vtb + (16 * tt + 8) * VIMG_LD + ((d ^ vq) * 64));
                o[d] = __builtin_amdgcn_mfma_f32_32x32x16_bf16(cat8(a0, a1), pb[tt], o[d], 0, 0, 0);
            }
        LDS_WAIT();
        if (MODE == 0) { if (__all(R < 1e-37f)) break; }
    }
    float inv = 1.f;
    if (MODE == 1) { lrun += __shfl_xor(lrun, 32); inv = 1.f / lrun; }
    bf16* orow = Op + (size_t)(q0 + n) * ldo + 4 * kg;
#pragma unroll
    for (int d = 0; d < 4; ++d)
#pragma unroll
        for (int i = 0; i < 4; ++i) { v2u w; w.x = pk2(o[d][4 * i] * inv, o[d][4 * i + 1] * inv); w.y = pk2(o[d][4 * i + 2] * inv, o[d][4 * i + 3] * inv); *(v2u*)(orow + d * 32 + 8 * i) = w; }
}

constexpr int SX_LD = 80, SB_LD = 272, SM_LD = 144;
constexpr int S_XI = 0, S_XWI = 5120, S_BI = 10240, S_CI = 27648, S_MI = 45056, S_SI = 54272, SSD_LDS = 62976;
__device__ __forceinline__ f32x4 mfma16(bf16x8 a, bf16x8 b, f32x4 c) { return __builtin_amdgcn_mfma_f32_16x16x32_bf16(a, b, c, 0, 0, 0); }
#define SSD_BAR() do { asm volatile("s_waitcnt lgkmcnt(0)" ::: "memory"); __builtin_amdgcn_s_barrier(); asm volatile("" ::: "memory"); } while (0)


constexpr int SX2_LD = 144, S_XI2 = 0;
__device__ __forceinline__ void ssd_pre(const bf16* XBC, const float* DT, const float* dt_bias, const float* a_log, const float* d_skip, bf16* MIXRAW, float* WL, float* EL, LAS unsigned char* L, int tid, int bx, int G) {
    asm volatile("" : "+v"(tid));
    const int lane = tid & 63, w = __builtin_amdgcn_readfirstlane(tid >> 6);
    const int fr = lane & 15, fq = lane >> 4, q4 = fr >> 2, p4 = fr & 3;
    for (int i = tid; i < 9216 / 16; i += 512) *(LAS v4u*)(L + S_MI + i * 16) = (v4u){0u, 0u, 0u, 0u};
    const int brow = tid >> 4, bch = tid & 15, xrow = tid >> 3, xch = tid & 7;
    for (int item = bx; item < BATCH * 32 * 16; item += G) {
        const int b = item >> 9, c = (item >> 4) & 31, h = item & 15, g = h >> 2;
        const float a = -fexp(a_log[h]), dtb = dt_bias[h], Dh = d_skip[h];
        const int row0 = b * SEQ + c * 64;
        const bf16* src = XBC + (size_t)row0 * 2048;
        v4u bq[2], cq[2], xq;
        {   const bf16* p = src + (size_t)brow * 2048 + 1024 + g * 128 + bch * 8;
            bq[0] = *(const v4u*)p; cq[0] = *(const v4u*)(p + 512); bq[1] = *(const v4u*)(p + 32 * 2048); cq[1] = *(const v4u*)(p + 32 * 2048 + 512);
            xq = *(const v4u*)(src + (size_t)xrow * 2048 + h * 64 + xch * 8); }
        const float dt = softplus_f(DT[(size_t)(row0 + lane) * 16 + h] + dtb);
        float cs = dt * a;
#pragma unroll
        for (int o = 1; o < 64; o <<= 1) { const float t = __shfl_up(cs, o); if (lane >= o) cs += t; }
        const float cs63 = __shfl(cs, 63);
        if (w == 0) { const size_t ti = (size_t)(b * 16 + h) * SEQ + c * 64 + lane; WL[ti] = dt * fexp(cs63 - cs); EL[ti] = fexp(cs); }
        *(LAS v4u*)(L + S_BI + brow * SB_LD + bch * 16) = bq[0]; *(LAS v4u*)(L + S_CI + brow * SB_LD + bch * 16) = cq[0];
        *(LAS v4u*)(L + S_BI + (brow + 32) * SB_LD + bch * 16) = bq[1]; *(LAS v4u*)(L + S_CI + (brow + 32) * SB_LD + bch * 16) = cq[1];
        *(LAS v4u*)(L + S_XI2 + xrow * SX2_LD + xch * 16) = xq;
        SSD_BAR();
#pragma unroll 1
        for (int t = w; t < 10; t += 8) {
            const int lt = (t >= 6) ? 3 : (t >= 3) ? 2 : (t >= 1) ? 1 : 0, st = t - (lt * (lt + 1)) / 2;
            const float csl = __shfl(cs, lt * 16 + fr);
            f32x4 acc = {0.f, 0.f, 0.f, 0.f};
#pragma unroll
            for (int ks = 0; ks < 4; ++ks) { const bf16x8 af = *(const LAS bf16x8*)(L + S_BI + (st * 16 + fr) * SB_LD + ks * 64 + fq * 16), bfr = *(const LAS bf16x8*)(L + S_CI + (lt * 16 + fr) * SB_LD + ks * 64 + fq * 16);
                acc = mfma16(af, bfr, acc); }
            float v[4];
#pragma unroll
            for (int j = 0; j < 4; ++j) { const int s = st * 16 + 4 * fq + j; const float css = __shfl(cs, s), dts = __shfl(dt, s);
                v[j] = (s <= lt * 16 + fr) ? acc[j] * fexp(csl - css) * dts : 0.f; }
            v2u mw; mw.x = pk2(v[0], v[1]); mw.y = pk2(v[2], v[3]);
            *(LAS v2u*)(L + S_MI + (lt * 16 + fr) * SM_LD + (st * 16 + 4 * fq) * 2) = mw;
        }
        SSD_BAR();
#pragma unroll
        for (int tt = 0; tt < 2; ++tt) {
            const int id = w * 2 + tt, pt = id >> 2, lt = id & 3;
            f32x4 yd = {0.f, 0.f, 0.f, 0.f};
#pragma unroll
            for (int ks = 0; ks < 2; ++ks) if (2 * ks <= lt) {
                const LAS unsigned char* xa = L + S_XI2 + (ks * 32 + fq * 8 + q4) * SX2_LD + (pt * 16 + 4 * p4) * 2;
                const bf16x8 af = cat8(vtr(xa), vtr(xa + 4 * SX2_LD)), bfr = *(const LAS bf16x8*)(L + S_MI + (lt * 16 + fr) * SM_LD + ks * 64 + fq * 16);
                yd = mfma16(af, bfr, yd); }
            const int l = lt * 16 + fr;
            const v2u xv = *(const LAS v2u*)(L + S_XI2 + l * SX2_LD + (pt * 16 + 4 * fq) * 2);
            v2u yw; yw.x = pk2(yd[0] + Dh * bflo(xv.x), yd[1] + Dh * bfhi(xv.x)); yw.y = pk2(yd[2] + Dh * bflo(xv.y), yd[3] + Dh * bfhi(xv.y));
            *(v2u*)(MIXRAW + (size_t)(row0 + (l & ~1) + (pt >> 1)) * 2048 + 1024 + h * 64 + (l & 1) * 32 + (pt & 1) * 16 + 4 * fq) = yw;
        }
        SSD_BAR();
    }
}
__device__ __forceinline__ void ssd_scan(int unit, const bf16* XBC, const float* WL, const float* EL, bf16* MIXRAW, LAS unsigned char* L, int tid) {
    asm volatile("" : "+v"(tid));
    const int lane = tid & 63, w = __builtin_amdgcn_readfirstlane(tid >> 6);
    const int b = unit >> 5, h = (unit >> 1) & 15, ph = unit & 1, g = h >> 2;
    const int fr = lane & 15, fq = lane >> 4, q4 = fr >> 2, p4 = fr & 3;
    f32x4 sacc[2] = {(f32x4){0.f, 0.f, 0.f, 0.f}, (f32x4){0.f, 0.f, 0.f, 0.f}};
    const bf16* src0 = XBC + (size_t)(b * SEQ) * 2048;
    const float* wl0 = WL + (size_t)(b * 16 + h) * SEQ; const float* el0 = EL + (size_t)(b * 16 + h) * SEQ;
    const int brow = tid >> 4, bch = tid & 15, xrow = (tid & 255) >> 2, xch = tid & 3;
    const int ypt = w >> 2, ylt = w & 3, yl = ylt * 16 + fr;
    bf16* yp0 = MIXRAW + (size_t)(b * SEQ + (yl & ~1) + ph) * 2048 + 1024 + h * 64 + (yl & 1) * 32 + ypt * 16 + 4 * fq;
    constexpr int PF = 4;
    v4u bq[PF][2], cq[PF][2], xq[PF]; v2u yq[PF]; float wlq[PF], elq[PF], e63q[PF];
#define SCAN_LOAD(k, cc) do { const int t1_ = (cc) * 64; const bf16* p_ = src0 + (size_t)(t1_ + brow) * 2048 + 1024 + g * 128 + bch * 8; \
        bq[k][0] = *(const v4u*)p_; cq[k][0] = *(const v4u*)(p_ + 512); bq[k][1] = *(const v4u*)(p_ + 32 * 2048); cq[k][1] = *(const v4u*)(p_ + 32 * 2048 + 512); \
        xq[k] = *(const v4u*)(src0 + (size_t)(t1_ + xrow) * 2048 + h * 64 + ph * 32 + xch * 8); \
        wlq[k] = wl0[t1_ + xrow]; elq[k] = el0[t1_ + yl]; e63q[k] = el0[t1_ + 63]; yq[k] = *(const v2u*)(yp0 + (size_t)t1_ * 2048); } while (0)
    constexpr int Q_XW = 0, Q_B = 5120, Q_C = 22528, Q_S = 39936, Q_SET = 49152;
#define SCAN_STAGE(k, set) do { LAS unsigned char* Ls_ = L + (set) * Q_SET; \
        *(LAS v4u*)(Ls_ + Q_B + brow * SB_LD + bch * 16) = bq[k][0]; *(LAS v4u*)(Ls_ + Q_C + brow * SB_LD + bch * 16) = cq[k][0]; \
        *(LAS v4u*)(Ls_ + Q_B + (brow + 32) * SB_LD + bch * 16) = bq[k][1]; *(LAS v4u*)(Ls_ + Q_C + (brow + 32) * SB_LD + bch * 16) = cq[k][1]; \
        if (w < 4) { const float wr_ = wlq[k]; const v4u xv4_ = xq[k]; v4u xw_; \
            xw_.x = pk2(bflo(xv4_.x) * wr_, bfhi(xv4_.x) * wr_); xw_.y = pk2(bflo(xv4_.y) * wr_, bfhi(xv4_.y) * wr_); xw_.z = pk2(bflo(xv4_.z) * wr_, bfhi(xv4_.z) * wr_); xw_.w = pk2(bflo(xv4_.w) * wr_, bfhi(xv4_.w) * wr_); \
            *(LAS v4u*)(Ls_ + Q_XW + xrow * SX_LD + xch * 16) = xw_; } \
        _Pragma("unroll") for (int pt_ = 0; pt_ < 2; ++pt_) { const f32x4 v_ = sacc[pt_]; v2u sw_; sw_.x = pk2(v_[0], v_[1]); sw_.y = pk2(v_[2], v_[3]); \
            *(LAS v2u*)(Ls_ + Q_S + (pt_ * 16 + fr) * SB_LD + (w * 16 + 4 * fq) * 2) = sw_; } } while (0)
#pragma unroll
    for (int k = 0; k < PF; ++k) SCAN_LOAD(k, k);
    SCAN_STAGE(0, 0);
    SSD_BAR();
    for (int c0 = 0; c0 < 32; c0 += PF) {
#pragma unroll
      for (int k = 0; k < PF; ++k) {
        const int c = c0 + k;
        const LAS unsigned char* Lc = L + (k & 1) * Q_SET;
        const float el = elq[k], e63 = e63q[k]; const v2u yv = yq[k];
        {   f32x4 yo = {0.f, 0.f, 0.f, 0.f};
#pragma unroll
            for (int ks = 0; ks < 4; ++ks) { const bf16x8 af = *(const LAS bf16x8*)(Lc + Q_S + (ypt * 16 + fr) * SB_LD + ks * 64 + fq * 16), bfr = *(const LAS bf16x8*)(Lc + Q_C + (ylt * 16 + fr) * SB_LD + ks * 64 + fq * 16);
                yo = mfma16(af, bfr, yo); }
            v2u yw; yw.x = pk2(bflo(yv.x) + el * yo[0], bfhi(yv.x) + el * yo[1]); yw.y = pk2(bflo(yv.y) + el * yo[2], bfhi(yv.y) + el * yo[3]);
            *(v2u*)(yp0 + (size_t)(c * 64) * 2048) = yw; }
#pragma unroll
        for (int pt = 0; pt < 2; ++pt) {
            f32x4 acc = sacc[pt] * e63;
#pragma unroll
            for (int ks = 0; ks < 2; ++ks) {
                const LAS unsigned char* ba = Lc + Q_B + (ks * 32 + fq * 8 + q4) * SB_LD + (w * 16 + 4 * p4) * 2;
                const LAS unsigned char* xa = Lc + Q_XW + (ks * 32 + fq * 8 + q4) * SX_LD + (pt * 16 + 4 * p4) * 2;
                acc = mfma16(cat8(vtr(ba), vtr(ba + 4 * SB_LD)), cat8(vtr(xa), vtr(xa + 4 * SX_LD)), acc); }
            sacc[pt] = acc; }
        if (c + 1 < 32) SCAN_STAGE((k + 1) % PF, (k + 1) & 1);
        if (c + PF < 32) SCAN_LOAD(k, c + PF);
        SSD_BAR();
      }
    }
#undef SCAN_STAGE
#undef SCAN_LOAD
}

#define XB_TMO      128
#define XB_XCNT(j)  (256  + 64 * (j))
#define XB_XSUB(j)  (1280 + 64 * (j))
#define XB_XGEN(j)  (2304 + 64 * (j))
#define XB_TOP      3328
#define XB_TOPGEN   3392
#define XCD_BAR_WORDS 3456
#define XB_SPIN_CAP (1u << 18)

__device__ __forceinline__ unsigned xb_ld(unsigned* p)              { return __hip_atomic_load(p, __ATOMIC_RELAXED, __HIP_MEMORY_SCOPE_AGENT); }
__device__ __forceinline__ unsigned xb_add(unsigned* p, unsigned v) { return __hip_atomic_fetch_add(p, v, __ATOMIC_RELAXED, __HIP_MEMORY_SCOPE_AGENT); }
__device__ __forceinline__ unsigned xb_xcc_id() { return (unsigned)__builtin_amdgcn_s_getreg((3 << 11) | 20) & 0xFu; }
#define XB_SPIN(cond, bar) do { unsigned _sp = 0; while (cond) { __builtin_amdgcn_s_sleep(1); \
    if ((++_sp & 255u) == 0u) { if (xb_ld(&(bar)[XB_TMO])) break; if (_sp > XB_SPIN_CAP) { atomicAdd(&(bar)[XB_TMO], 1u); break; } } } } while (0)

struct XcdBarrier {
    unsigned* bar; unsigned x; unsigned w0;
    volatile LAS unsigned* st;
};

__device__ __forceinline__ XcdBarrier xcd_barrier_post(unsigned* bar, volatile LAS unsigned* st) {
    XcdBarrier b; b.bar = bar; b.x = xb_xcc_id(); b.st = st;
    if (threadIdx.x == 0) (void)xb_add(&bar[XB_XCNT(b.x)], 1u);
    return b;
}
__device__ __forceinline__ void xcd_barrier_complete(unsigned* bar, unsigned x, unsigned& nloc, unsigned& nx) {
    const unsigned G = gridDim.x * gridDim.y * gridDim.z;
    unsigned sum, cnt, mine, sp = 0u;
    for (;;) {
        sum = 0u; cnt = 0u; mine = 0u;
#pragma unroll
        for (unsigned j = 0; j < 16; ++j) { const unsigned c = xb_ld(&bar[XB_XCNT(j)]); sum += c; cnt += (c > 0u) ? 1u : 0u; mine = (j == x) ? c : mine; }
        if (sum == G) break;
        __builtin_amdgcn_s_sleep(1);
        if ((++sp & 255u) == 0u) { if (xb_ld(&bar[XB_TMO])) break; if (sp > XB_SPIN_CAP) { atomicAdd(&bar[XB_TMO], 1u); break; } }
    }
    nloc = mine > 0u ? mine : 1u; nx = cnt > 0u ? cnt : 1u;
}

__device__ __forceinline__ void xcd_barrier(const XcdBarrier& b) {
    asm volatile("s_waitcnt vmcnt(0)" ::: "memory");
    __syncthreads();
    if (b.w0 && pg8::hw_lane() == 0) {
        unsigned* bar = b.bar;
        __builtin_amdgcn_s_waitcnt(0);
        unsigned nloc = b.st[0], nx = b.st[1];
        if (nloc == 0u) { xcd_barrier_complete(bar, b.x, nloc, nx); b.st[0] = nloc; b.st[1] = nx; }
        const unsigned old = xb_add(&bar[XB_XSUB(b.x)], 1u);
        const unsigned gen = old / nloc;
        if (old + 1u == (gen + 1u) * nloc) {
            __builtin_amdgcn_fence(__ATOMIC_RELEASE, "agent");
            asm volatile("s_waitcnt vmcnt(0)" ::: "memory");
            const unsigned og = xb_add(&bar[XB_TOP], 1u);
            const unsigned tg = og / nx;
            if (og + 1u == (tg + 1u) * nx) xb_add(&bar[XB_TOPGEN], 1u);
            else XB_SPIN(xb_ld(&bar[XB_TOPGEN]) == tg, bar);
            __builtin_amdgcn_fence(__ATOMIC_ACQUIRE, "agent");
            xb_add(&bar[XB_XGEN(b.x)], 1u);
            asm volatile("s_waitcnt vmcnt(0)" ::: "memory");
        } else {
            XB_SPIN(xb_ld(&bar[XB_XGEN(b.x)]) == gen, bar);
            __builtin_amdgcn_fence(__ATOMIC_ACQUIRE, "agent");
            asm volatile("s_waitcnt vmcnt(0)" ::: "memory");
        }
    }
    __syncthreads();
}

__global__ void __launch_bounds__(NWAVES * 64, 2) fwd_megakernel(Args A) {
    extern __shared__ __attribute__((aligned(16))) unsigned char lds_raw[];
    cg::grid_group grid = cg::this_grid();
    LAS unsigned char* lds = (LAS unsigned char*)lds_raw;
    const int wave = __builtin_amdgcn_readfirstlane((int)threadIdx.x >> 6); int lane = pg8::hw_lane();
#define tid (wave * 64 + lane)
#define PHASE_FENCE() do { lane = pg8::hw_lane(); asm volatile("" : "+v"(lane)); } while (0)
    const int G = gridDim.x, bx = blockIdx.x;
    const int gw = bx * NWAVES + wave, NGW = G * NWAVES;
    unsigned char* ws = A.ws;
    bf16* U = (bf16*)(ws + WS_U); bf16* Y = (bf16*)(ws + WS_Y); bf16* BIG = (bf16*)(ws + WS_BIG);
    bf16* QM = (bf16*)(ws + WS_QM); bf16* OM = (bf16*)(ws + WS_OM); bf16* KVM = (bf16*)(ws + WS_KVM); float* DT = (float*)(ws + WS_DT);
    float* H = A.out; bf16* H16 = (bf16*)A.out; float* RS = (float*)(ws + WS_RS);
    typedef pg8::StaticOrder SO;
    if (tid < 64) ((LAS unsigned*)(lds + 131072))[tid] = 0u;
    __syncthreads();
    XcdBarrier xbar; xbar.bar = (unsigned*)(ws + WS_CTL); xbar.x = xb_xcc_id(); xbar.st = (volatile LAS unsigned*)(lds + 131072); xbar.w0 = (wave == 0) ? 1u : 0u;
    if (tid == 0) ((volatile LAS unsigned*)(lds + 131072))[4] = xb_add(&xbar.bar[XB_XCNT(xbar.x)], 1u);
    __syncthreads();
    const int xrank = (int)((volatile LAS unsigned*)(lds + 131072))[4], xcc = (int)xbar.x;
#define GRID_BAR() do { xcd_barrier(xbar); PHASE_FENCE(); } while (0)

    p0_prologue(A, lds, gw, NGW, wave, lane);
    if (G > (1 << 20)) grid.sync();
    GRID_BAR();
    bool okmap = (G % 8 == 0) && xcc < 8 && xrank < G / 8;
#pragma unroll
    for (int j = 0; j < 8; ++j) okmap = okmap && (xb_ld(&xbar.bar[XB_XCNT(j)]) == (unsigned)(G / 8));
    okmap = __syncthreads_and(okmap ? 1 : 0) != 0;
    const int cx = __builtin_amdgcn_readfirstlane(okmap ? xrank * 8 + xcc : bx);
    const int vcu = __builtin_amdgcn_readfirstlane(okmap ? xcc * (G / 8) + xrank : bx);
    { pg8::Gemm g{U, (const bf16*)(ws + WS_W1GU), T, 2 * FF, D, D}; g.wid = wave; SO S; S.init(T, 2 * FF, G, cx); pg8::EpiSwiGLU E{BIG, FF, RS};
      pg8::gemm_phase<pg8::EpiSwiGLU, SO, true, true>(lds, g, S, E); }
    __syncthreads();
    { pg8::Gemm g{(const bf16*)(ws + WS_MN), (const bf16*)(ws + WS_WMKV), BATCH * NMEM, 2 * MEMW, D, D}; g.wid = wave; SO S; S.init(BATCH * NMEM, 2 * MEMW, G, (cx + 32) % G); pg8::EpiBf16 E{KVM, 2 * MEMW, nullptr};
      pg8::gemm_phase<pg8::EpiBf16, SO, true, true>(lds, g, S, E); }
    GRID_BAR();
    { pg8::Gemm g{BIG, (const bf16*)(ws + WS_W1D), T, D, FF, FF}; g.wid = wave; SO S; S.init(T, D, G, cx); pg8::EpiBf16 E{Y, D, nullptr};
      pg8::gemm_phase<pg8::EpiBf16, SO, true, true>(lds, g, S, E); }
    GRID_BAR();
    norm_phase<true, true, false>(Y, A.in[0], nullptr, H16, nullptr, A.in[6], 0.5f, RS, gw, NGW, lane);
    GRID_BAR();
    { pg8::Gemm g{H16, (const bf16*)(ws + WS_WIN), T, PROJ_LD, D, D}; g.wid = wave; SO S; S.init(T, PROJ_LD, G, cx); pg8::EpiBf16 E{BIG, PROJ_LD, RS};
      pg8::gemm_phase<pg8::EpiBf16, SO, true, true>(lds, g, S, E); }
    GRID_BAR();
    {   LAS unsigned char* vimg = lds + wave * VIMG_BYTES;
#pragma unroll 1
        for (int stage = 0; stage < 2; ++stage) {
            if (((wave & 1) != 0) == (stage == 0)) {
                for (int u = gw; u < BATCH * 8 * 64; u += NGW) {
                    const int qb = u & 63, hh = (u >> 6) & 7, b = u >> 9;
                    const bf16* base = BIG + (size_t)b * SEQ * PROJ_LD + hh * 128;
                    attn_unit<0>(base + QOFF, PROJ_LD, base + KOFF, base + VOFF, PROJ_LD, qb * 32, qb, U + (size_t)b * SEQ * D + hh * 128, D, vimg, lane);
                }
            } else {
                conv_phase(BIG, A.in[9], A.in[10], Y, gw, NGW, lane);
                if ((wave & 1) == 0) dt_phase(H16, D, RS, (const bf16*)(ws + WS_WIN) + (size_t)PROJ_LD * D, DT, gw >> 1, NGW >> 1, lane);
            }
            PHASE_FENCE();
        } }
    GRID_BAR();
    ssd_pre(Y, DT, A.in[11], A.in[12], A.in[13], U, (float*)(ws + WS_WL), (float*)(ws + WS_EL), lds, tid, vcu, G);
    GRID_BAR();
    for (int unit = vcu; unit < BATCH * 32; unit += G) ssd_scan(unit, Y, (const float*)(ws + WS_WL), (const float*)(ws + WS_EL), U, lds, tid);
    GRID_BAR();
    mixnorm_phase(U, BIG, A.in[14], A.in[15], gw, NGW, lane);
    GRID_BAR();
    { pg8::Gemm g{U, (const bf16*)(ws + WS_WOUT), T, D, D, D}; g.wid = wave; SO S; S.init(T, D, G, cx); pg8::EpiBf16 E{Y, D, nullptr};
      pg8::gemm_phase<pg8::EpiBf16, SO, true, true>(lds, g, S, E); }
    GRID_BAR();
    norm_phase<true, false, false>(Y, nullptr, H16, H16, nullptr, A.in[17], 1.0f, RS, gw, NGW, lane);
    GRID_BAR();
    { constexpr int NU = (T / 256) * (MEMW / 256);
      if (cx < NU || G <= NU) { pg8::Gemm g{H16, (const bf16*)(ws + WS_WMQ), T, MEMW, D, D}; g.wid = wave; SO S; S.init(T, MEMW, G, cx); pg8::EpiBf16 E{QM, MEMW, RS};
      pg8::gemm_phase<pg8::EpiBf16, SO, true, true>(lds, g, S, E); }
      if (G <= NU) { __syncthreads(); ffn2_weights(A, lds, gw, NGW, wave, lane); }
      else if (cx >= NU) ffn2_weights(A, lds, (cx - NU) * NWAVES + wave, (G - NU) * NWAVES, wave, lane); }
    GRID_BAR();
    { LAS unsigned char* vimg = lds + wave * VIMG_BYTES;
      for (int u = gw; u < BATCH * 4 * 64; u += NGW) {
          const int qb = u & 63, hh = (u >> 6) & 3, b = u >> 8;
          const bf16* kv = KVM + (size_t)b * NMEM * (2 * MEMW) + hh * 128;
          attn_unit<1>(QM + (size_t)b * SEQ * MEMW + hh * 128, MEMW, kv, kv + MEMW, 2 * MEMW, qb * 32, NMEM / 32 - 1, OM + (size_t)b * SEQ * MEMW + hh * 128, MEMW, vimg, lane);
      } }
    GRID_BAR();
    { pg8::Gemm g{OM, (const bf16*)(ws + WS_WMO), T, D, MEMW, MEMW}; g.wid = wave; SO S; S.init(T, D, G, cx); pg8::EpiBf16 E{Y, D, nullptr};
      pg8::gemm_phase<pg8::EpiBf16, SO, true, true>(lds, g, S, E); }
    GRID_BAR();
    norm_phase<true, false, false, true>(Y, nullptr, H16, U, nullptr, A.in[23], 1.0f, RS, gw, NGW, lane, (unsigned char*)BIG + 96 * MiB);
    for (int i = gw * 64 + lane; i < T * 8; i += NGW * 64) *(v4u*)((unsigned char*)BIG + (size_t)(i >> 3) * ACT8_LD + FF + (i & 7) * 16) = (v4u){0u, 0u, 0u, 0u};
    GRID_BAR();
    { pg8::Gemm g{(const bf16*)((unsigned char*)BIG + 96 * MiB), (const bf16*)(ws + WS_W2GU), T, 2 * FF, D / 2, D / 2}; g.wid = wave; SO S; S.init(T, 2 * FF, G, cx);
      pg8::EpiSwiGLU8 E{(unsigned char*)BIG, ACT8_LD, 1.0f / W2GU_SCALE};
      pg8::gemm_phase<pg8::EpiSwiGLU8, SO, true, true, true>(lds, g, S, E); }
    GRID_BAR();
    { pg8::Gemm g{BIG, (const bf16*)(ws + WS_W2D), T, D, ACT8_LD / 2, ACT8_LD / 2}; g.wid = wave; SO S; S.init(T, D, G, cx); pg8::EpiBf16S E{Y, D, 1.0f / W2D_SCALE};
      pg8::gemm_phase<pg8::EpiBf16S, SO, true, true, true>(lds, g, S, E); }
    GRID_BAR();
    norm_phase<false, false, true>(Y, nullptr, U, nullptr, H, A.in[28], 0.5f, nullptr, gw, NGW, lane);
}

#undef tid
extern "C" void kernel_launch(void* const* d_in, const int* in_sizes, int n_in, void* d_out, int out_size, void* d_ws, size_t ws_size, hipStream_t stream) {
    static int grid = 0;
    if (grid == 0) {
        if (n_in != 29 || in_sizes[0] != T * D || out_size != T * D || ws_size < WS_TOP2) { fprintf(stderr, "kernel_launch: unexpected problem: n_in %d in0 %d out %d ws %zu (need %zu)\n", n_in, n_in > 0 ? in_sizes[0] : -1, out_size, ws_size, (size_t)WS_END); grid = -1; return; }
        int dev = 0, cus = 0, per_cu = 0;
        hipGetDevice(&dev); hipDeviceGetAttribute(&cus, hipDeviceAttributeMultiprocessorCount, dev);
        if (hipFuncSetAttribute((const void*)fwd_megakernel, hipFuncAttributeMaxDynamicSharedMemorySize, LDS_BYTES) != hipSuccess) { fprintf(stderr, "kernel_launch: hipFuncSetAttribute failed\n"); grid = -1; return; }
        if (hipOccupancyMaxActiveBlocksPerMultiprocessor(&per_cu, (const void*)fwd_megakernel, NWAVES * 64, LDS_BYTES) != hipSuccess || per_cu < 1) { fprintf(stderr, "kernel_launch: occupancy query says %d blocks per CU\n", per_cu); per_cu = 1; }
        (void)hipGetLastError();
        grid = cus * per_cu;
    }
    if (grid < 0) return;
    if (hipMemsetAsync((char*)d_ws + WS_CTL, 0, CTL_BYTES, stream) != hipSuccess) { fprintf(stderr, "kernel_launch: hipMemsetAsync failed\n"); return; }
    Args a{};
    for (int i = 0; i < 29; ++i) a.in[i] = (const float*)d_in[i];
    a.out = (float*)d_out; a.ws = (unsigned char*)d_ws;
    void* args[] = {&a};
    hipError_t e = hipLaunchCooperativeKernel((const void*)fwd_megakernel, dim3(grid), dim3(NWAVES * 64), args, LDS_BYTES, stream);
    if (e != hipSuccess) fprintf(stderr, "kernel_launch: cooperative launch failed: %s (grid %d)\n", hipGetErrorString(e), grid);
}
```

```cpp
#include <hip/hip_runtime.h>
#include <hip/hip_cooperative_groups.h>
#include <cstdio>
#include <cstdint>
namespace cg = cooperative_groups;

namespace pg8 {
#define PG8_LAS __attribute__((address_space(3)))
typedef unsigned short bf16_t;
typedef short bf16x8 __attribute__((ext_vector_type(8)));
typedef float f32x4 __attribute__((ext_vector_type(4)));
typedef unsigned u32x4 __attribute__((ext_vector_type(4)));
constexpr int BM = 256, BK = 64, HALF = 128, HTB = HALF * BK * 2  , STAGE_BYTES = 8 * HTB, NXCD = 8, WGM = 8;

__host__ __device__ __forceinline__ int lds_byte(int r, int c) { const int st = (r >> 4) * 2 + (c >> 5), rr = r & 15, cc = c & 31, ob = rr * 64 + cc * 2; return st * 1024 + (ob ^ (((ob >> 9) & 1) << 5)); }
__host__ __device__ __forceinline__ void stage_rc(int b, int& R, int& C) { const int st = b / 1024, sb = b % 1024, swz = sb ^ (((sb >> 9) & 1) << 5); R = (st >> 1) * 16 + swz / 64; C = (st & 1) * 32 + (swz % 64) / 2; }
__host__ __device__ __forceinline__ int perm32(int rho) { const int n = rho >> 4, i = rho & 15; return 8 * (i >> 2) + 4 * n + (i & 3); }

struct Unit { int pm, pn; };
struct Gemm { const bf16_t* A; const bf16_t* Bt; int M, N, K; int lda; int wid = 0; };

struct StaticOrder {
    int nM, nN, nwg, G, c;
    __host__ __device__ void init(int M, int N, int G_, int c_) { nM = M / BM; nN = N / BM; nwg = nM * nN; G = G_; c = c_; }
    __host__ __device__ bool next(int i, Unit& u) const {
        const long L = (long)i * G + c; if (L >= nwg) return false;
        int wgid = (int)L; { const int q = nwg / NXCD, r = nwg % NXCD, xcd = wgid % NXCD, off = wgid / NXCD; wgid = (xcd < r ? xcd * (q + 1) : r * (q + 1) + (xcd - r) * q) + off; }
        const int nig = WGM * nN, gid = wgid / nig, fm = gid * WGM, gsz = (nM - fm) < WGM ? (nM - fm) : WGM;
        u.pm = fm + ((wgid % nig) % gsz); u.pn = (wgid % nig) / gsz; return true;
    }
    __device__ __forceinline__ void a_ready(const Unit&) const {}
    __device__ __forceinline__ void done(const Unit&) const {}
};

typedef __bf16 bf16x2_t __attribute__((ext_vector_type(2)));
typedef float f32x2_t __attribute__((ext_vector_type(2)));
__device__ __forceinline__ unsigned cvt_pk_bf16(float lo, float hi) { f32x2_t v = {lo, hi}; bf16x2_t b = __builtin_convertvector(v, bf16x2_t); return __builtin_bit_cast(unsigned, b); }
__device__ __forceinline__ float silu_f(float x) { return x * __builtin_amdgcn_rcpf(1.0f + __builtin_amdgcn_exp2f(-1.4426950408889634f * x)); }

__device__ __forceinline__ int hw_lane() { unsigned z = 0u; asm volatile("" : "+v"(z)); return (int)__builtin_amdgcn_mbcnt_hi(~0u, __builtin_amdgcn_mbcnt_lo(~0u, z)); }
typedef int v8i32 __attribute__((ext_vector_type(8)));
typedef int v4i32 __attribute__((ext_vector_type(4)));
__device__ __forceinline__ v8i32 cat16(v4i32 lo, v4i32 hi) { return __builtin_shufflevector(lo, hi, 0, 1, 2, 3, 4, 5, 6, 7); }
__device__ __forceinline__ unsigned pk4_fp8(float a, float b, float c, float d) { unsigned w = 0u;
    a = __builtin_amdgcn_fmed3f(a, -448.f, 448.f); b = __builtin_amdgcn_fmed3f(b, -448.f, 448.f); c = __builtin_amdgcn_fmed3f(c, -448.f, 448.f); d = __builtin_amdgcn_fmed3f(d, -448.f, 448.f);
    w = __builtin_amdgcn_cvt_pk_fp8_f32(a, b, w, false); w = __builtin_amdgcn_cvt_pk_fp8_f32(c, d, w, true); return w; }
struct EpiBf16 {
    static constexpr bool PERM = true, AFTER_DRAIN = false;
    bf16_t* O; int ldc; const float* rscale; float cs = 1.0f;
    __device__ __forceinline__ void operator()(const f32x4 (&acc)[2][2][4][2], const Unit& u, int wr, int wc, int fr, int fq) const {
        { int l_ = hw_lane(); asm volatile("" : "+v"(l_)); fr = l_ & 15; fq = l_ >> 4; }
        const int row0 = u.pm * BM + wr * 64 + fr; const int col0 = u.pn * BM + wc * 32 + 8 * fq;
        float rsv[2][4];
#pragma unroll
        for (int ai = 0; ai < 2; ++ai)
#pragma unroll
            for (int m = 0; m < 4; ++m) rsv[ai][m] = (rscale ? rscale[row0 + ai * HALF + m * 16] : 1.0f) * cs;
#pragma unroll
        for (int ai = 0; ai < 2; ++ai)
#pragma unroll
            for (int m = 0; m < 4; ++m) { bf16_t* rowp = O + (size_t)(row0 + ai * HALF + m * 16) * ldc + col0; const float rs = rsv[ai][m];
#pragma unroll
                for (int bj = 0; bj < 2; ++bj) { const f32x4 v0 = acc[ai][bj][m][0] * rs, v1 = acc[ai][bj][m][1] * rs;
                    u32x4 w; w.x = cvt_pk_bf16(v0[0], v0[1]); w.y = cvt_pk_bf16(v0[2], v0[3]); w.z = cvt_pk_bf16(v1[0], v1[1]); w.w = cvt_pk_bf16(v1[2], v1[3]);
                    *(u32x4*)(rowp + bj * HALF) = w; } }
    }
};
struct EpiBf16S {
    static constexpr bool PERM = true, AFTER_DRAIN = false;
    bf16_t* O; int ldc; float cs;
    __device__ __forceinline__ void operator()(const f32x4 (&acc)[2][2][4][2], const Unit& u, int wr, int wc, int fr, int fq) const {
        { int l_ = hw_lane(); asm volatile("" : "+v"(l_)); fr = l_ & 15; fq = (l_ >> 4) & 3; }
        typedef __attribute__((address_space(1))) char gchar;
        gchar* const base = (gchar*)O + ((size_t)(u.pm * BM + wr * 64) * ldc + u.pn * BM + wc * 32) * 2;
        const unsigned lo = (unsigned)(fr * ldc + 8 * fq) * 2u;
#pragma unroll
        for (int ai = 0; ai < 2; ++ai)
#pragma unroll
            for (int m = 0; m < 4; ++m) {
#pragma unroll
                for (int bj = 0; bj < 2; ++bj) { const f32x4 v0 = acc[ai][bj][m][0] * cs, v1 = acc[ai][bj][m][1] * cs;
                    u32x4 w; w.x = cvt_pk_bf16(v0[0], v0[1]); w.y = cvt_pk_bf16(v0[2], v0[3]); w.z = cvt_pk_bf16(v1[0], v1[1]); w.w = cvt_pk_bf16(v1[2], v1[3]);
                    *(__attribute__((address_space(1))) u32x4*)(base + (size_t)((ai * HALF + m * 16) * ldc + bj * HALF) * 2 + lo) = w; } }
    }
};
struct EpiSwiGLU8 {
    static constexpr bool PERM = true, AFTER_DRAIN = false;
    unsigned char* O8; int ldc; float cs;
    __device__ __forceinline__ void operator()(const f32x4 (&acc)[2][2][4][2], const Unit& u, int wr, int wc, int fr, int fq) const {
        { int l_ = hw_lane(); asm volatile("" : "+v"(l_)); fr = l_ & 15; fq = (l_ >> 4) & 3; }
        typedef __attribute__((address_space(1))) char gchar; typedef unsigned u32x2 __attribute__((ext_vector_type(2)));
        gchar* const base = (gchar*)O8 + (size_t)(u.pm * BM + wr * 64) * ldc + u.pn * HALF + wc * 32;
        const unsigned lo = (unsigned)(fr * ldc + 8 * fq);
#pragma unroll
        for (int ai = 0; ai < 2; ++ai)
#pragma unroll
            for (int m = 0; m < 4; ++m) {
                const f32x4 g0 = acc[ai][0][m][0] * cs, g1 = acc[ai][0][m][1] * cs, u0 = acc[ai][1][m][0] * cs, u1 = acc[ai][1][m][1] * cs;
                u32x2 w; w.x = pk4_fp8(silu_f(g0[0]) * u0[0], silu_f(g0[1]) * u0[1], silu_f(g0[2]) * u0[2], silu_f(g0[3]) * u0[3]);
                w.y = pk4_fp8(silu_f(g1[0]) * u1[0], silu_f(g1[1]) * u1[1], silu_f(g1[2]) * u1[2], silu_f(g1[3]) * u1[3]);
                *(__attribute__((address_space(1))) u32x2*)(base + (size_t)((ai * HALF + m * 16) * ldc) + lo) = w; }
    }
};
struct EpiSwiGLU {
    static constexpr bool PERM = true, AFTER_DRAIN = false;
    bf16_t* O; int ldc; const float* rscale;
    __device__ __forceinline__ void operator()(const f32x4 (&acc)[2][2][4][2], const Unit& u, int wr, int wc, int fr, int fq) const {
        const int row0 = u.pm * BM + wr * 64 + fr; const int col0 = u.pn * HALF + wc * 32 + 8 * fq;
        float rsv[2][4];
#pragma unroll
        for (int ai = 0; ai < 2; ++ai)
#pragma unroll
            for (int m = 0; m < 4; ++m) rsv[ai][m] = rscale[row0 + ai * HALF + m * 16];
#pragma unroll
        for (int ai = 0; ai < 2; ++ai)
#pragma unroll
            for (int m = 0; m < 4; ++m) { bf16_t* rowp = O + (size_t)(row0 + ai * HALF + m * 16) * ldc + col0;
                const float rs = rsv[ai][m];
                const f32x4 g0 = acc[ai][0][m][0] * rs, g1 = acc[ai][0][m][1] * rs, u0 = acc[ai][1][m][0] * rs, u1 = acc[ai][1][m][1] * rs;
                u32x4 w; w.x = cvt_pk_bf16(silu_f(g0[0]) * u0[0], silu_f(g0[1]) * u0[1]); w.y = cvt_pk_bf16(silu_f(g0[2]) * u0[2], silu_f(g0[3]) * u0[3]);
                w.z = cvt_pk_bf16(silu_f(g1[0]) * u1[0], silu_f(g1[1]) * u1[1]); w.w = cvt_pk_bf16(silu_f(g1[2]) * u1[2], silu_f(g1[3]) * u1[3]);
                *(u32x4*)rowp = w; }
    }
};

template <class Epi, class Sched, bool ALIGN_EPI = false, bool SP2 = false, bool FP8 = false>
__device__ __forceinline__ void gemm_phase(PG8_LAS unsigned char* lds, const Gemm g, const Sched& S, const Epi& E) {
    int tid_l = g.wid * 64 + hw_lane(); asm volatile("" : "+v"(tid_l));
    const int tid = tid_l, wid = __builtin_amdgcn_readfirstlane(tid >> 6), lane = tid & 63, wr = wid >> 2, wc = wid & 3, fr = lane & 15, fq = lane >> 4;
    const int K = g.K, nt = K / BK;
    unsigned voffA, voffB;
    { int R, C; stage_rc(tid * 16, R, C); const int Rb = Epi::PERM ? ((R & ~31) + perm32(R & 31)) : R;
      voffA = (unsigned)(R * g.lda + C) * 2u; voffB = (unsigned)(Rb * K + C) * 2u; }
    const size_t voffA_r64 = (size_t)64 * g.lda * 2, voffB_r64 = (size_t)64 * K * 2;
    const size_t kstep = (size_t)(BK * 2);
    const size_t hstep = (size_t)HALF * K * 2;
    const size_t tstep = 2 * hstep;
    const size_t hstepA = (size_t)HALF * g.lda * 2, tstepA = 2 * hstepA;
    const unsigned ldsw = (unsigned)wid * 1024u; const unsigned ldsbase_ = (unsigned)(size_t)lds;
    const int aoff = lds_byte(wr * 64 + fr, fq * 8), boff = lds_byte(wc * 32 + fr, fq * 8);
#define PG8_SA(b, h) (((b) * 2 + (h)) * HTB)
#define PG8_SB(b, h) ((4 + (b) * 2 + (h)) * HTB)
#define PG8_STAGE(bufoff, gbase, voff) do { _Pragma("unroll") for (int _i = 0; _i < 2; ++_i) { unsigned keep_; \
        asm volatile("s_mov_b32 %0, m0\n\ts_mov_b32 m0, %3\n\ts_nop 0\n\tglobal_load_lds_dwordx4 %1, %2\n\ts_mov_b32 m0, %0" : "=&s"(keep_) \
            : "v"(voff), "s"((const char*)(gbase) + (size_t)_i * voff##_r64), "s"((unsigned)(ldsbase_ + (bufoff) + ldsw + _i * 8192)) : "memory"); } } while (0)
#define PG8_LDA(dst, b, h) do { if constexpr (FP8) { _Pragma("unroll") for (int m = 0; m < 4; ++m) dst##8[m] = cat16(*(const PG8_LAS v4i32*)(lds + PG8_SA(b, h) + aoff + m * 2048), *(const PG8_LAS v4i32*)(lds + PG8_SA(b, h) + aoff + m * 2048 + 1024)); } \
        else { _Pragma("unroll") for (int m = 0; m < 4; ++m) _Pragma("unroll") for (int k = 0; k < 2; ++k) dst[m][k] = *(const PG8_LAS bf16x8*)(lds + PG8_SA(b, h) + aoff + m * 2048 + k * 1024); } } while (0)
#define PG8_LDB(dst, b, h) do { if constexpr (FP8) { _Pragma("unroll") for (int n = 0; n < 2; ++n) dst##8[n] = cat16(*(const PG8_LAS v4i32*)(lds + PG8_SB(b, h) + boff + n * 2048), *(const PG8_LAS v4i32*)(lds + PG8_SB(b, h) + boff + n * 2048 + 1024)); } \
        else { _Pragma("unroll") for (int n = 0; n < 2; ++n) _Pragma("unroll") for (int k = 0; k < 2; ++k) dst[n][k] = *(const PG8_LAS bf16x8*)(lds + PG8_SB(b, h) + boff + n * 2048 + k * 1024); } } while (0)
#define PG8_MMA(ai, bj, At, Bt) do { __builtin_amdgcn_s_setprio(1); \
        if constexpr (FP8) { _Pragma("unroll") for (int m = 0; m < 4; ++m) _Pragma("unroll") for (int n = 0; n < 2; ++n) \
            acc[ai][bj][m][n] = __builtin_amdgcn_mfma_scale_f32_16x16x128_f8f6f4(Bt##8[n], At##8[m], acc[ai][bj][m][n], 0, 0, 0, 127, 0, 127); } \
        else { _Pragma("unroll") for (int m = 0; m < 4; ++m) _Pragma("unroll") for (int n = 0; n < 2; ++n) _Pragma("unroll") for (int k = 0; k < 2; ++k) \
            acc[ai][bj][m][n] = __builtin_amdgcn_mfma_f32_16x16x32_bf16(Bt[n][k], At[m][k], acc[ai][bj][m][n], 0, 0, 0); } \
        __builtin_amdgcn_s_setprio(0); } while (0)
#define PG8_WAIT_V(n) asm volatile("s_waitcnt vmcnt(" #n ")" ::: "memory")
#define PG8_WAIT_L(n) asm volatile("s_waitcnt lgkmcnt(" #n ")" ::: "memory")
#define PG8_BAR __builtin_amdgcn_s_barrier()
#define PG8_SCHED __builtin_amdgcn_sched_barrier(0)
    Unit cur, nxt; int ui = 0;
    if (!S.next(0, cur)) return;
    f32x4 acc[2][2][4][2];
#pragma unroll
    for (int a = 0; a < 2; ++a)
#pragma unroll
        for (int b = 0; b < 2; ++b)
#pragma unroll
            for (int m = 0; m < 4; ++m)
#pragma unroll
                for (int n = 0; n < 2; ++n) acc[a][b][m][n] = (f32x4){0.f, 0.f, 0.f, 0.f};
    bf16x8 At[4][2], B0[2][2], B1[2][2]; v8i32 At8[4], B08[2], B18[2];
    const char* cA = (const char*)g.A + (size_t)cur.pm * tstepA; const char* cB = (const char*)g.Bt + (size_t)cur.pn * tstep;
    S.a_ready(cur);
    if constexpr (SP2) {
        PG8_STAGE(PG8_SB(0, 0), cB, voffB); PG8_STAGE(PG8_SB(0, 1), cB + hstep, voffB); PG8_STAGE(PG8_SA(0, 0), cA, voffA); PG8_STAGE(PG8_SA(0, 1), cA + hstepA, voffA);
        if (wr == 1) PG8_BAR;
        PG8_WAIT_V(2); PG8_BAR;
        PG8_STAGE(PG8_SB(1, 0), cB + kstep, voffB); PG8_STAGE(PG8_SA(1, 0), cA + kstep, voffA); PG8_STAGE(PG8_SB(1, 1), cB + hstep + kstep, voffB);
        PG8_WAIT_V(6); PG8_BAR;
    } else {
        PG8_STAGE(PG8_SB(0, 0), cB, voffB); PG8_STAGE(PG8_SA(0, 0), cA, voffA); PG8_STAGE(PG8_SB(0, 1), cB + hstep, voffB); PG8_STAGE(PG8_SA(0, 1), cA + hstepA, voffA);
        if (wr == 1) PG8_BAR;
        PG8_WAIT_V(4); PG8_BAR;
        PG8_STAGE(PG8_SB(1, 0), cB + kstep, voffB); PG8_STAGE(PG8_SA(1, 0), cA + kstep, voffA); PG8_STAGE(PG8_SB(1, 1), cB + hstep + kstep, voffB);
        PG8_WAIT_V(6); PG8_BAR;
    }
    for (;;) {
        const bool has_next = S.next(ui + 1, nxt);
        const char* nA = has_next ? (const char*)g.A + (size_t)nxt.pm * tstepA : cA; const char* nB = has_next ? (const char*)g.Bt + (size_t)nxt.pn * tstep : cB;
        for (int t = 0; t < nt; t += 2) {
            const bool last = (t == nt - 2);
            const char* a1 = cA + (size_t)(t + 1) * kstep;
            const char* a2 = last ? nA : cA + (size_t)(t + 2) * kstep; const char* b2 = last ? nB : cB + (size_t)(t + 2) * kstep;
            const char* a3 = a2 + kstep; const char* b3 = b2 + kstep;
            if (last && has_next) S.a_ready(nxt);
            if constexpr (SP2) {
            PG8_LDB(B0, 0, 0); PG8_LDB(B1, 0, 1); PG8_SCHED; PG8_LDA(At, 0, 0); PG8_STAGE(PG8_SA(1, 1), a1 + hstepA, voffA);
            PG8_WAIT_V(8); PG8_WAIT_L(0); PG8_BAR; PG8_MMA(0, 0, At, B0); PG8_MMA(0, 1, At, B1); PG8_BAR; PG8_SCHED;
            PG8_LDA(At, 0, 1); PG8_STAGE(PG8_SB(0, 0), b2, voffB); PG8_STAGE(PG8_SB(0, 1), b2 + hstep, voffB); PG8_STAGE(PG8_SA(0, 0), a2, voffA);
            PG8_WAIT_V(8); PG8_WAIT_L(0); PG8_BAR; PG8_MMA(1, 0, At, B0); PG8_MMA(1, 1, At, B1); PG8_BAR; PG8_SCHED;
            PG8_LDB(B0, 1, 0); PG8_LDB(B1, 1, 1); PG8_SCHED; PG8_LDA(At, 1, 0); PG8_STAGE(PG8_SA(0, 1), a2 + hstepA, voffA);
            PG8_WAIT_V(8); PG8_WAIT_L(0); PG8_BAR; PG8_MMA(0, 0, At, B0); PG8_MMA(0, 1, At, B1); PG8_BAR; PG8_SCHED;
            PG8_LDA(At, 1, 1); PG8_STAGE(PG8_SB(1, 0), b3, voffB); PG8_STAGE(PG8_SB(1, 1), b3 + hstep, voffB); PG8_STAGE(PG8_SA(1, 0), a3, voffA);
            PG8_WAIT_V(8); PG8_WAIT_L(0); PG8_BAR; PG8_MMA(1, 0, At, B0); PG8_MMA(1, 1, At, B1); PG8_BAR; PG8_SCHED;
            } else {
            PG8_LDB(B0, 0, 0); PG8_SCHED; PG8_LDA(At, 0, 0); PG8_STAGE(PG8_SA(1, 1), a1 + hstepA, voffA);
            PG8_WAIT_L(8); PG8_BAR; PG8_WAIT_L(0); PG8_MMA(0, 0, At, B0); PG8_BAR; PG8_SCHED;
            PG8_LDB(B1, 0, 1); PG8_STAGE(PG8_SB(0, 0), b2, voffB);
            PG8_BAR; PG8_WAIT_L(0); PG8_MMA(0, 1, At, B1); PG8_BAR;
            PG8_LDA(At, 0, 1); PG8_STAGE(PG8_SA(0, 0), a2, voffA);
            PG8_BAR; PG8_WAIT_L(0); PG8_MMA(1, 0, At, B0); PG8_BAR; PG8_SCHED;
            PG8_STAGE(PG8_SB(0, 1), b2 + hstep, voffB);
            PG8_WAIT_V(6); PG8_BAR; PG8_MMA(1, 1, At, B1); PG8_BAR;
            PG8_LDB(B0, 1, 0); PG8_SCHED; PG8_LDA(At, 1, 0); PG8_STAGE(PG8_SA(0, 1), a2 + hstepA, voffA);
            PG8_WAIT_L(8); PG8_BAR; PG8_WAIT_L(0); PG8_MMA(0, 0, At, B0); PG8_BAR; PG8_SCHED;
            PG8_LDB(B1, 1, 1); PG8_STAGE(PG8_SB(1, 0), b3, voffB);
            PG8_BAR; PG8_WAIT_L(0); PG8_MMA(0, 1, At, B1); PG8_BAR;
            PG8_LDA(At, 1, 1); PG8_STAGE(PG8_SA(1, 0), a3, voffA);
            PG8_BAR; PG8_WAIT_L(0); PG8_MMA(1, 0, At, B0); PG8_BAR; PG8_SCHED;
            PG8_STAGE(PG8_SB(1, 1), b3 + hstep, voffB);
            PG8_WAIT_V(6); PG8_BAR; PG8_MMA(1, 1, At, B1); PG8_BAR;
            }
        }
        if constexpr (ALIGN_EPI) { if (wr == 0) PG8_BAR; }
        if constexpr (!Epi::AFTER_DRAIN) { E(acc, cur, wr, wc, fr, fq); S.done(cur); }
        if (!has_next) break;
#pragma unroll
        for (int a = 0; a < 2; ++a)
#pragma unroll
            for (int b = 0; b < 2; ++b)
#pragma unroll
                for (int m = 0; m < 4; ++m)
#pragma unroll
                    for (int n = 0; n < 2; ++n) acc[a][b][m][n] = (f32x4){0.f, 0.f, 0.f, 0.f};
        cur = nxt; cA = nA; cB = nB; ++ui;
        if constexpr (ALIGN_EPI) { if (wr == 1) PG8_BAR; }
    }
    PG8_WAIT_V(0);
    if constexpr (!ALIGN_EPI) { if (wr == 0) PG8_BAR; }
    PG8_BAR;
    if constexpr (Epi::AFTER_DRAIN) { E.fused(acc, cur, wr, wc, fr, fq, lds, wid, lane); S.done(cur); }
#undef PG8_SA
#undef PG8_SB
#undef PG8_STAGE
#undef PG8_LDA
#undef PG8_LDB
#undef PG8_MMA
#undef PG8_WAIT_V
#undef PG8_WAIT_L
#undef PG8_BAR
#undef PG8_SCHED
}
}
constexpr int NWAVES = 8;
constexpr int BATCH = 8, SEQ = 2048, D = 2048, T = BATCH * SEQ, FF = 5504, NMEM = 256;
constexpr int INP = 6160, PROJ_LD = 6144, INP_PAD = 6400;
constexpr int QOFF = 0, KOFF = 1024, VOFF = 2048, ZOFF = 3072, XBCOFF = 4096;
constexpr int MEMW = 512;
constexpr int ACT8_LD = 5632;
constexpr float W2GU_SCALE = 32.0f;
constexpr float W2D_SCALE = 64.0f;
constexpr float EPS = 1e-6f;
constexpr size_t MiB = 1u << 20;
constexpr size_t WS_W1GU = 0, WS_W1D = 43 * MiB, WS_W2GU = WS_W1D + 43 * MiB / 2, WS_W2D = WS_W2GU + 43 * MiB, WS_WIN = 129 * MiB, WS_WOUT = 154 * MiB,
                 WS_WMQ = 162 * MiB, WS_WMKV = 164 * MiB, WS_WMO = 168 * MiB, WS_MN = 170 * MiB, WS_KVM = 178 * MiB, WS_DT = 182 * MiB,
                 WS_U = 184 * MiB, WS_Y = 248 * MiB, WS_BIG = 312 * MiB, WS_END = 504 * MiB;
static_assert(WS_W2D + 43 * MiB / 2 == WS_WIN, "ws map");
constexpr size_t WS_CTL = WS_END, CTL_BYTES = 16384;
constexpr size_t WS_WL = WS_END + 65536, WS_EL = WS_WL + MiB, WS_TOP = WS_EL + MiB;
constexpr size_t WS_RS = WS_TOP, WS_TOP2 = WS_RS + 65536;
constexpr size_t WS_QM = WS_BIG, WS_OM = WS_BIG + 16 * MiB;
constexpr int LDS_BYTES = 131072 + 1024;

#define GAS __attribute__((address_space(1)))
#define LAS __attribute__((address_space(3)))
typedef unsigned short bf16;
typedef unsigned v4u __attribute__((ext_vector_type(4)));
typedef unsigned v2u __attribute__((ext_vector_type(2)));
typedef float f32x4 __attribute__((ext_vector_type(4)));
typedef float f32x16 __attribute__((ext_vector_type(16)));
typedef short bf16x8 __attribute__((ext_vector_type(8)));
typedef short s16x4 __attribute__((ext_vector_type(4)));
typedef short v4i16_t __attribute__((ext_vector_type(4)));
#define LDS_WAIT() asm volatile("s_waitcnt lgkmcnt(0)" ::: "memory")
#define CFENCE() asm volatile("" ::: "memory")
__device__ __forceinline__ unsigned f2bf(float f) { unsigned u = __builtin_bit_cast(unsigned, f); return (u + 0x7fffu + ((u >> 16) & 1u)) >> 16; }
typedef __bf16 bf16x2_t __attribute__((ext_vector_type(2)));
typedef float f32x2_t __attribute__((ext_vector_type(2)));
__device__ __forceinline__ unsigned pk2(float lo, float hi) { f32x2_t v = {lo, hi}; bf16x2_t b = __builtin_convertvector(v, bf16x2_t); return __builtin_bit_cast(unsigned, b); }
__device__ __forceinline__ float bflo(unsigned w) { return __builtin_bit_cast(float, w << 16); }
__device__ __forceinline__ float bfhi(unsigned w) { return __builtin_bit_cast(float, w & 0xffff0000u); }
__device__ __forceinline__ float fexp(float x) { return __builtin_amdgcn_exp2f(1.4426950408889634f * x); }
__device__ __forceinline__ float flog(float x) { return 0.6931471805599453f * __builtin_amdgcn_logf(x); }
__device__ __forceinline__ float silu(float x) { return x * __builtin_amdgcn_rcpf(1.0f + fexp(-x)); }
__device__ __forceinline__ float softplus_f(float x) { return fmaxf(x, 0.f) + flog(1.0f + fexp(-fabsf(x))); }
__device__ __forceinline__ s16x4 vtr(const LAS unsigned char* p) { return __builtin_bit_cast(s16x4, __builtin_amdgcn_ds_read_tr16_b64_v4i16((LAS v4i16_t*)p)); }
__device__ __forceinline__ bf16x8 cat8(s16x4 a, s16x4 b) { bf16x8 r; r[0] = a[0]; r[1] = a[1]; r[2] = a[2]; r[3] = a[3]; r[4] = b[0]; r[5] = b[1]; r[6] = b[2]; r[7] = b[3]; return r; }
__device__ __forceinline__ float wave_sum(float v) {
#pragma unroll
    for (int o = 1; o < 64; o <<= 1) v += __shfl_xor(v, o);
    return v;
}

__device__ __forceinline__ float wave_sum_l(float v, int lane) {
#pragma unroll
    for (int o = 1; o < 64; o <<= 1) v += __builtin_bit_cast(float, __builtin_amdgcn_ds_bpermute((lane ^ o) << 2, __builtin_bit_cast(int, v)));
    return v;
}
__device__ __forceinline__ void transpose_item(const float* __restrict__ W, int ldw, int K, bf16* WT, int k0, int n0, int drow0, LAS float* scr, int lane, const float* kg) {
    float v[32];
#pragma unroll
    for (int i = 0; i < 32; ++i) v[i] = W[(size_t)(k0 + 2 * i + (lane >> 5)) * ldw + n0 + (lane & 31)];
    const int c = lane & 7;
    f32x4 ga = {1.f, 1.f, 1.f, 1.f}, gb = ga;
    if (kg) { ga = *(const f32x4*)(kg + k0 + 8 * c); gb = *(const f32x4*)(kg + k0 + 8 * c + 4); }
#pragma unroll
    for (int i = 0; i < 32; ++i) scr[(2 * i + (lane >> 5)) * 33 + (lane & 31)] = v[i];
    LDS_WAIT();
#pragma unroll
    for (int j = 0; j < 4; ++j) { const int n = (lane >> 3) + 8 * j; const LAS float* s = scr + (8 * c) * 33 + n;
        v4u o; o.x = pk2(s[0 * 33] * ga.x, s[1 * 33] * ga.y); o.y = pk2(s[2 * 33] * ga.z, s[3 * 33] * ga.w); o.z = pk2(s[4 * 33] * gb.x, s[5 * 33] * gb.y); o.w = pk2(s[6 * 33] * gb.z, s[7 * 33] * gb.w);
        *(v4u*)(WT + (size_t)(drow0 + n) * K + k0 + 8 * c) = o; }
    LDS_WAIT();
}
__device__ __forceinline__ void transpose_item8(const float* __restrict__ W, int ldw, int ldt, unsigned char* WT, int k0, int n0, int drow0, LAS float* scr, int lane, float sc, const float* kg = nullptr) {
    float v[32];
#pragma unroll
    for (int i = 0; i < 32; ++i) v[i] = W[(size_t)(k0 + 2 * i + (lane >> 5)) * ldw + n0 + (lane & 31)];
    const int c = lane & 7;
    f32x4 ga = {sc, sc, sc, sc}, gb = ga;
    if (kg) { ga = ga * *(const f32x4*)(kg + k0 + 8 * c); gb = gb * *(const f32x4*)(kg + k0 + 8 * c + 4); }
#pragma unroll
    for (int i = 0; i < 32; ++i) scr[(2 * i + (lane >> 5)) * 33 + (lane & 31)] = v[i];
    LDS_WAIT();
#pragma unroll
    for (int j = 0; j < 4; ++j) { const int n = (lane >> 3) + 8 * j; const LAS float* s = scr + (8 * c) * 33 + n;
        v2u o; o.x = pg8::pk4_fp8(s[0 * 33] * ga.x, s[1 * 33] * ga.y, s[2 * 33] * ga.z, s[3 * 33] * ga.w); o.y = pg8::pk4_fp8(s[4 * 33] * gb.x, s[5 * 33] * gb.y, s[6 * 33] * gb.z, s[7 * 33] * gb.w);
        *(v2u*)(WT + (size_t)(drow0 + n) * ldt + k0 + 8 * c) = o; }
    LDS_WAIT();
}
__device__ __forceinline__ void tr_plain(int r, const float* W, int ldw, int K, int nblk, bf16* WT, LAS float* scr, int lane, const float* kg = nullptr) {
    const int kb = r / nblk, nb = r % nblk; transpose_item(W, ldw, K, WT, 64 * kb, 32 * nb, 32 * nb, scr, lane, kg);
}
__device__ __forceinline__ void tr_gu(int r, const float* W, bf16* WT, int up, LAS float* scr, int lane, const float* kg) {
    const int nblk = FF / 32, kb = r / nblk, nb = r % nblk, n0 = 32 * nb; transpose_item(W, FF, D, WT, 64 * kb, n0, 256 * (n0 >> 7) + (n0 & 127) + 128 * up, scr, lane, kg);
}
__device__ __forceinline__ void rms_row_to_bf16(const float* xrow, const float* gain, bf16* orow, int lane) {
    const f32x4* xr = (const f32x4*)xrow + lane; const f32x4* gr = (const f32x4*)gain + lane;
    f32x4 v[8]; float s = 0.f;
#pragma unroll
    for (int j = 0; j < 8; ++j) { v[j] = xr[64 * j]; s += (v[j].x * v[j].x + v[j].y * v[j].y) + (v[j].z * v[j].z + v[j].w * v[j].w); }
    const float rstd = __builtin_amdgcn_rsqf(wave_sum(s) * (1.f / D) + EPS);
    v2u* o8 = (v2u*)orow + lane;
#pragma unroll
    for (int j = 0; j < 8; ++j) { const f32x4 g = gr[64 * j]; v2u w; w.x = pk2(v[j].x * rstd * g.x, v[j].y * rstd * g.y); w.y = pk2(v[j].z * rstd * g.z, v[j].w * rstd * g.w); o8[64 * j] = w; }
}

struct Args { const float* in[29]; float* out; unsigned char* ws; };

__device__ __forceinline__ void p0_prologue(const Args& A, LAS unsigned char* lds, int gw, int NGW, int wave, int lane) {
    LAS float* scr = (LAS float*)(lds + wave * 8704);
    unsigned char* ws = A.ws;
    constexpr int I_GU = (D / 64) * (FF / 32), I_DN = (FF / 64) * (D / 32), I_IN = (D / 64) * (PROJ_LD / 32), I_INT = 256, I_OUT = (D / 64) * (D / 32),
                  I_MQ = (D / 64) * (MEMW / 32), I_MKV = (D / 64) * (2 * MEMW / 32), I_MO = (MEMW / 64) * (D / 32);
    constexpr int NITEMS = 2 * I_GU + I_DN + I_IN + I_INT + I_OUT + I_MQ + I_MKV + I_MO;
    for (int it = gw; it < NITEMS; it += NGW) {
        int r = it;
        if (r < I_GU) { tr_gu(r, A.in[3], (bf16*)(ws + WS_W1GU), 0, scr, lane, A.in[2]); continue; } r -= I_GU;
        if (r < I_GU) { tr_gu(r, A.in[4], (bf16*)(ws + WS_W1GU), 1, scr, lane, A.in[2]); continue; } r -= I_GU;
        if (r < I_DN) { tr_plain(r, A.in[5], D, FF, D / 32, (bf16*)(ws + WS_W1D), scr, lane); continue; } r -= I_DN;
        if (r < I_IN) { tr_plain(r, A.in[8], INP, D, PROJ_LD / 32, (bf16*)(ws + WS_WIN), scr, lane, A.in[7]); continue; } r -= I_IN;
        if (r < I_INT) {
            bf16* dst = (bf16*)(ws + WS_WIN) + (size_t)(PROJ_LD + r) * D + lane * 32; const float* W = A.in[8];
#pragma unroll
            for (int q = 0; q < 4; ++q) { v4u o = {0u, 0u, 0u, 0u};
                if (r < 16) { float f[8];
#pragma unroll
                    for (int e = 0; e < 8; ++e) f[e] = A.in[7][lane * 32 + q * 8 + e] * W[(size_t)(lane * 32 + q * 8 + e) * INP + PROJ_LD + r];
                    o.x = pk2(f[0], f[1]); o.y = pk2(f[2], f[3]); o.z = pk2(f[4], f[5]); o.w = pk2(f[6], f[7]); }
                *(v4u*)(dst + q * 8) = o; }
            continue; } r -= I_INT;
        if (r < I_OUT) { tr_plain(r, A.in[16], D, D, D / 32, (bf16*)(ws + WS_WOUT), scr, lane); continue; } r -= I_OUT;
        if (r < I_MQ) { tr_plain(r, A.in[20], MEMW, D, MEMW / 32, (bf16*)(ws + WS_WMQ), scr, lane, A.in[18]); continue; } r -= I_MQ;
        if (r < I_MKV) { tr_plain(r, A.in[21], 2 * MEMW, D, 2 * MEMW / 32, (bf16*)(ws + WS_WMKV), scr, lane); continue; } r -= I_MKV;
        tr_plain(r, A.in[22], D, MEMW, D / 32, (bf16*)(ws + WS_WMO), scr, lane);
    }
    for (int m = gw; m < T; m += NGW) {
        const f32x4* xr = (const f32x4*)(A.in[0] + (size_t)m * D) + lane; v2u* o8 = (v2u*)((bf16*)(ws + WS_U) + (size_t)m * D) + lane; float ss = 0.f;
#pragma unroll
        for (int j = 0; j < 8; ++j) { const f32x4 v = xr[64 * j]; ss += (v.x * v.x + v.y * v.y) + (v.z * v.z + v.w * v.w); v2u w; w.x = pk2(v.x, v.y); w.y = pk2(v.z, v.w); o8[64 * j] = w; }
        ss = wave_sum(ss); if (lane == 0) ((float*)(ws + WS_RS))[m] = __builtin_amdgcn_rsqf(ss * (1.f / D) + EPS); }
    for (int m = gw; m < BATCH * NMEM; m += NGW) rms_row_to_bf16(A.in[1] + (size_t)m * D, A.in[19], (bf16*)(ws + WS_MN) + (size_t)m * D, lane);
}

__device__ __forceinline__ void ffn2_weights(const Args& A, LAS unsigned char* lds, int gw2, int NGW2, int wave, int lane) {
    LAS float* scr = (LAS float*)(lds + wave * 8704);
    unsigned char* ws = A.ws;
    constexpr int I_GU = (D / 64) * (FF / 32), I_DN = (FF / 64) * (D / 32);
    for (int it = gw2; it < 2 * I_GU + I_DN; it += NGW2) {
        int r = it;
        if (r < 2 * I_GU) { const int up = r >= I_GU ? 1 : 0, rr = r - up * I_GU, nblk = FF / 32, kb = rr / nblk, nb = rr % nblk, n0 = 32 * nb;
            transpose_item8(A.in[25 + up], FF, D, ws + WS_W2GU, 64 * kb, n0, 256 * (n0 >> 7) + (n0 & 127) + 128 * up, scr, lane, W2GU_SCALE, A.in[24]); continue; } r -= 2 * I_GU;
        { const int kb = r / (D / 32), nb = r % (D / 32); transpose_item8(A.in[27], D, ACT8_LD, ws + WS_W2D, 64 * kb, 32 * nb, 32 * nb, scr, lane, W2D_SCALE); }
    }
    for (int i = gw2 * 64 + lane; i < D * 8; i += NGW2 * 64) *(v4u*)(ws + WS_W2D + (size_t)(i >> 3) * ACT8_LD + FF + (i & 7) * 16) = (v4u){0u, 0u, 0u, 0u};
}
template <bool NEXT, bool IN_F32, bool OUT_F32, bool OUT8 = false>
__device__ __forceinline__ void norm_phase(const bf16* Y, const float* xin, const bf16* Hin, bf16* Hout, float* out, const float* gpost, float coef, float* RS, int gw, int NGW, int lane, unsigned char* H8 = nullptr) {
    for (int m = gw; m < T; m += NGW) {
        const v2u* yr = (const v2u*)(Y + (size_t)m * D) + lane;
        f32x4 y[8], h[8]; float s = 0.f;
#pragma unroll
        for (int j = 0; j < 8; ++j) { const v2u w = yr[64 * j];
            if (IN_F32) h[j] = ((const f32x4*)(xin + (size_t)m * D))[64 * j + lane];
            else { const v2u hw = ((const v2u*)(Hin + (size_t)m * D))[64 * j + lane]; h[j] = (f32x4){bflo(hw.x), bfhi(hw.x), bflo(hw.y), bfhi(hw.y)}; }
            y[j] = (f32x4){bflo(w.x), bfhi(w.x), bflo(w.y), bfhi(w.y)};
            s += (y[j].x * y[j].x + y[j].y * y[j].y) + (y[j].z * y[j].z + y[j].w * y[j].w); }
        const float rs = coef * __builtin_amdgcn_rsqf(wave_sum_l(s, lane) * (1.f / D) + EPS);
        float s2 = 0.f;
#pragma unroll
        for (int j = 0; j < 8; ++j) { const f32x4 g = ((const f32x4*)gpost)[64 * j + lane]; h[j] = h[j] + y[j] * rs * g;
            s2 += (h[j].x * h[j].x + h[j].y * h[j].y) + (h[j].z * h[j].z + h[j].w * h[j].w); }
        asm volatile("" ::: "memory");
#pragma unroll
        for (int j = 0; j < 8; ++j) {
            if (OUT_F32) ((f32x4*)(out + (size_t)m * D))[64 * j + lane] = h[j];
            else { v2u hw; hw.x = pk2(h[j].x, h[j].y); hw.y = pk2(h[j].z, h[j].w); ((v2u*)(Hout + (size_t)m * D))[64 * j + lane] = hw; }
            }
        if (NEXT) { const float r2 = __builtin_amdgcn_rsqf(wave_sum_l(s2, lane) * (1.f / D) + EPS); if (lane == 0) RS[m] = r2;
            if (OUT8) {
#pragma unroll
                for (int j = 0; j < 8; ++j) ((unsigned*)(H8 + (size_t)m * D))[64 * j + lane] = pg8::pk4_fp8(h[j].x * r2, h[j].y * r2, h[j].z * r2, h[j].w * r2); } }
    }
}
__device__ __forceinline__ void mixnorm_phase(bf16* MIX, const bf16* PROJ, const float* gsb, const float* gssm, int gw, int NGW, int lane) {
    for (int pr = gw; pr < T / 2; pr += NGW) {
        float v[2][4][8]; float ssb[2] = {0.f, 0.f}, sy[2] = {0.f, 0.f};
#pragma unroll
        for (int r = 0; r < 2; ++r) { const int m = 2 * pr + r;
            const v4u* zr = (const v4u*)(PROJ + (size_t)m * PROJ_LD + ZOFF) + lane;
#pragma unroll
            for (int j = 0; j < 4; ++j) { v4u w;
                if (j < 2) w = ((const v4u*)(MIX + (size_t)m * D))[64 * j + lane];
                else { const int off = 8 * (64 * (j - 2) + lane), hh = off >> 6, ph = (off >> 5) & 1, p0 = off & 31;
                       w = *(const v4u*)(MIX + (size_t)(2 * pr + ph) * D + 1024 + hh * 64 + r * 32 + p0); }
                v[r][j][0] = bflo(w.x); v[r][j][1] = bfhi(w.x); v[r][j][2] = bflo(w.y); v[r][j][3] = bfhi(w.y); v[r][j][4] = bflo(w.z); v[r][j][5] = bfhi(w.z); v[r][j][6] = bflo(w.w); v[r][j][7] = bfhi(w.w);
                if (j >= 2) { const v4u z = zr[64 * (j - 2)]; float zf[8] = {bflo(z.x), bfhi(z.x), bflo(z.y), bfhi(z.y), bflo(z.z), bfhi(z.z), bflo(z.w), bfhi(z.w)};
#pragma unroll
                    for (int e = 0; e < 8; ++e) { v[r][j][e] *= silu(zf[e]); sy[r] += v[r][j][e] * v[r][j][e]; } }
                else {
#pragma unroll
                    for (int e = 0; e < 8; ++e) ssb[r] += v[r][j][e] * v[r][j][e]; } } }
        asm volatile("" ::: "memory");
#pragma unroll
        for (int r = 0; r < 2; ++r) { const int m = 2 * pr + r;
            const float rsb = __builtin_amdgcn_rsqf(wave_sum(ssb[r]) * (1.f / 1024.f) + EPS), ry = __builtin_amdgcn_rsqf(wave_sum(sy[r]) * (1.f / 1024.f) + EPS);
            v4u* mr = (v4u*)(MIX + (size_t)m * D) + lane;
#pragma unroll
            for (int j = 0; j < 4; ++j) { const float* g = (j < 2 ? gsb : gssm) + 8 * (64 * (j & 1) + lane); const f32x4 g0 = *(const f32x4*)g, g1 = *(const f32x4*)(g + 4); const float rr = j < 2 ? rsb : ry;
                v4u w; w.x = pk2(v[r][j][0] * rr * g0.x, v[r][j][1] * rr * g0.y); w.y = pk2(v[r][j][2] * rr * g0.z, v[r][j][3] * rr * g0.w); w.z = pk2(v[r][j][4] * rr * g1.x, v[r][j][5] * rr * g1.y); w.w = pk2(v[r][j][6] * rr * g1.z, v[r][j][7] * rr * g1.w);
                mr[64 * j] = w; } }
    }
}
__device__ __forceinline__ void conv_phase(const bf16* PROJ, const float* cw, const float* cb, bf16* XBC, int gw, int NGW, int lane) {
    for (int it = gw; it < (T / 32) * 4; it += NGW) {
        const int rb = it >> 2, c0 = ((it & 3) * 64 + lane) * 8, t0 = rb * 32;
        float w[4][8], bias[8];
#pragma unroll
        for (int k = 0; k < 4; ++k) { const f32x4 a = *(const f32x4*)(cw + k * 2048 + c0), b = *(const f32x4*)(cw + k * 2048 + c0 + 4); w[k][0] = a.x; w[k][1] = a.y; w[k][2] = a.z; w[k][3] = a.w; w[k][4] = b.x; w[k][5] = b.y; w[k][6] = b.z; w[k][7] = b.w; }
        { const f32x4 a = *(const f32x4*)(cb + c0), b = *(const f32x4*)(cb + c0 + 4); bias[0] = a.x; bias[1] = a.y; bias[2] = a.z; bias[3] = a.w; bias[4] = b.x; bias[5] = b.y; bias[6] = b.z; bias[7] = b.w; }
        const bf16* src = PROJ + (size_t)t0 * PROJ_LD + XBCOFF + c0;
        v4u r0 = {0u, 0u, 0u, 0u}, r1 = r0, r2 = r0;
        if ((t0 & (SEQ - 1)) != 0) { r0 = *(const v4u*)(src - 3 * PROJ_LD); r1 = *(const v4u*)(src - 2 * PROJ_LD); r2 = *(const v4u*)(src - PROJ_LD); }
#pragma unroll 4
        for (int i = 0; i < 32; ++i) {
            const v4u r3 = *(const v4u*)(src + (size_t)i * PROJ_LD);
            float o[8];
#pragma unroll
            for (int e = 0; e < 8; ++e) { const unsigned a0 = r0[e >> 1], a1 = r1[e >> 1], a2 = r2[e >> 1], a3 = r3[e >> 1];
                const float x0 = (e & 1) ? bfhi(a0) : bflo(a0), x1 = (e & 1) ? bfhi(a1) : bflo(a1), x2 = (e & 1) ? bfhi(a2) : bflo(a2), x3 = (e & 1) ? bfhi(a3) : bflo(a3);
                o[e] = silu(bias[e] + w[0][e] * x0 + w[1][e] * x1 + w[2][e] * x2 + w[3][e] * x3); }
            v4u ow; ow.x = pk2(o[0], o[1]); ow.y = pk2(o[2], o[3]); ow.z = pk2(o[4], o[5]); ow.w = pk2(o[6], o[7]);
            *(v4u*)(XBC + (size_t)(t0 + i) * 2048 + c0) = ow;
            r0 = r1; r1 = r2; r2 = r3;
        }
    }
}
__device__ __forceinline__ void dt_phase(const bf16* Ub, int ldu, const float* RS, const bf16* Wdt, float* DT, int gw, int NGW, int lane) {
    const int fr = lane & 15, fq = lane >> 4;
    for (int task = gw; task < T / 16; task += NGW) {
        const bf16* ap = Ub + (size_t)(task * 16 + fr) * ldu + fq * 8; const bf16* bp = Wdt + (size_t)fr * D + fq * 8;
        f32x4 acc0 = {0.f, 0.f, 0.f, 0.f}, acc1 = {0.f, 0.f, 0.f, 0.f};
#pragma unroll 4
        for (int ks = 0; ks < 64; ks += 2) {
            const bf16x8 a0 = *(const bf16x8*)(ap + ks * 32), b0 = *(const bf16x8*)(bp + ks * 32), a1 = *(const bf16x8*)(ap + ks * 32 + 32), b1 = *(const bf16x8*)(bp + ks * 32 + 32);
            acc0 = __builtin_amdgcn_mfma_f32_16x16x32_bf16(a0, b0, acc0, 0, 0, 0); acc1 = __builtin_amdgcn_mfma_f32_16x16x32_bf16(a1, b1, acc1, 0, 0, 0); }
        const f32x4 acc = acc0 + acc1;
#pragma unroll
        for (int r = 0; r < 4; ++r) DT[(size_t)(task * 16 + 4 * fq + r) * 16 + fr] = acc[r] * RS[task * 16 + 4 * fq + r];
    }
}
constexpr int VIMG_LD = 256, VIMG_BYTES = 32 * VIMG_LD;
template <int MODE>
__device__ __forceinline__ void attn_unit(const bf16* Qp, int ldq, const bf16* Kp, const bf16* Vp, int ldkv, int q0, int kt_start, bf16* Op, int ldo, LAS unsigned char* vimg, int lane) {
    asm volatile("" : "+v"(lane));
    const int n = lane & 31, kg = lane >> 5;
    bf16x8 qf[8], kf[8];
    { const bf16* qr = Qp + (size_t)(q0 + n) * ldq + kg * 8;
#pragma unroll
      for (int ks = 0; ks < 8; ++ks) qf[ks] = *(const bf16x8*)(qr + ks * 16); }
    { const bf16* kr = Kp + (size_t)(kt_start * 32 + n) * ldkv + kg * 8;
#pragma unroll
      for (int ks = 0; ks < 8; ++ks) kf[ks] = *(const bf16x8*)(kr + ks * 16); }
    f32x16 o[4];
#pragma unroll
    for (int d = 0; d < 4; ++d)
#pragma unroll
        for (int e = 0; e < 16; ++e) o[d][e] = 0.f;
    float R = 1.f, mrun = -1e30f, lrun = 0.f;
    const float scale = 0.08838834764831845f;
    const int gi = lane & 15, G = lane >> 4;
    const int vq = gi >> 2;
    const LAS unsigned char* vtb = vimg + (4 * (G >> 1) + vq) * VIMG_LD + (2 * (G & 1) + ((gi & 3) >> 1)) * 16 + 8 * (gi & 1);
    for (int kt = kt_start; kt >= 0; --kt) {
        { const bf16* vsrc = Vp + (size_t)(kt * 32 + (lane >> 4)) * ldkv + (((lane & 15) ^ (((lane >> 4) & 3) << 2)) * 8);
#pragma unroll
          for (int k = 0; k < 8; ++k) __builtin_amdgcn_global_load_lds((const unsigned*)(vsrc + (size_t)(4 * k) * ldkv), (LAS unsigned*)(vimg + k * 1024), 16, 0, 0); }
        f32x16 s;
#pragma unroll
        for (int e = 0; e < 16; ++e) s[e] = 0.f;
#pragma unroll
        for (int ks = 0; ks < 8; ++ks) s = __builtin_amdgcn_mfma_f32_32x32x16_bf16(kf[ks], qf[ks], s, 0, 0, 0);
        float p[16];
        if (MODE == 0) {
            const int t = q0 + n, kb = kt * 32 + 4 * kg; const bool diag = (kt * 32 + 31 >= q0);
            float kp[16], g[4];
#pragma unroll
            for (int i = 0; i < 4; ++i) { g[i] = 1.f;
#pragma unroll
                for (int j = 0; j < 4; ++j) { const int e = 4 * i + j; const bool valid = !diag || (kb + 8 * i + j < t);
                    const float r = __builtin_amdgcn_rcpf(1.0f + fexp(s[e] * scale));
                    kp[e] = valid ? r : 1.f; p[e] = valid ? 1.0f - r : 0.f; g[i] *= kp[e]; } }
            float og[4];
#pragma unroll
            for (int i = 0; i < 4; ++i) og[i] = __shfl_xor(g[i], 32);
            float carry = R;
#pragma unroll
            for (int i = 3; i >= 0; --i) {
                float c = carry * (kg == 0 ? og[i] : 1.f);
#pragma unroll
                for (int j = 3; j >= 0; --j) { const int e = 4 * i + j; p[e] *= c; c *= kp[e]; }
                carry *= g[i] * og[i];
            }
            R = carry;
        } else {
            float tm = -1e30f;
#pragma unroll
            for (int e = 0; e < 16; ++e) { s[e] *= scale; tm = fmaxf(tm, s[e]); }
            tm = fmaxf(tm, __shfl_xor(tm, 32));
            const float mn = fmaxf(mrun, tm), alpha = fexp(mrun - mn); mrun = mn; float ls = 0.f;
#pragma unroll
            for (int e = 0; e < 16; ++e) { p[e] = fexp(s[e] - mn); ls += p[e]; }
            lrun = lrun * alpha + ls;
#pragma unroll
            for (int d = 0; d < 4; ++d)
#pragma unroll
                for (int e = 0; e < 16; ++e) o[d][e] *= alpha;
        }
        bf16x8 pb[2];
#pragma unroll
        for (int tt = 0; tt < 2; ++tt) { v4u w; w.x = pk2(p[8 * tt + 0], p[8 * tt + 1]); w.y = pk2(p[8 * tt + 2], p[8 * tt + 3]); w.z = pk2(p[8 * tt + 4], p[8 * tt + 5]); w.w = pk2(p[8 * tt + 6], p[8 * tt + 7]);
            pb[tt] = __builtin_bit_cast(bf16x8, w); }
        asm volatile("s_waitcnt vmcnt(0)" ::: "memory");
        if (kt > 0) { const bf16* kr = Kp + (size_t)((kt - 1) * 32 + n) * ldkv + kg * 8;
#pragma unroll
            for (int ks = 0; ks < 8; ++ks) kf[ks] = *(const bf16x8*)(kr + ks * 16); }
#pragma unroll
        for (int d = 0; d < 4; ++d)
#pragma unroll
            for (int tt = 0; tt < 2; ++tt) {
                const s16x4 a0 = vtr(vtb + (16 * tt) * VIMG_LD + ((d ^ vq) * 64)), a1 = vtr(vtb + (16 * tt + 8) * VIMG_LD + ((d ^ vq) * 64));
                o[d] = __builtin_amdgcn_mfma_f32_32x32x16_bf16(cat8(a0, a1), pb[tt], o[d], 0, 0, 0);
            }
        LDS_WAIT();
        if (MODE == 0) { if (__all(R < 1e-37f)) break; }
    }
    float inv = 1.f;
    if (MODE == 1) { lrun += __shfl_xor(lrun, 32); inv = 1.f / lrun; }
    bf16* orow = Op + (size_t)(q0 + n) * ldo + 4 * kg;
#pragma unroll
    for (int d = 0; d < 4; ++d)
#pragma unroll
        for (int i = 0; i < 4; ++i) { v2u w; w.x = pk2(o[d][4 * i] * inv, o[d][4 * i + 1] * inv); w.y = pk2(o[d][4 * i + 2] * inv, o[d][4 * i + 3] * inv); *(v2u*)(orow + d * 32 + 8 * i) = w; }
}

constexpr int SX_LD = 80, SB_LD = 272, SM_LD = 144;
constexpr int S_XI = 0, S_XWI = 5120, S_BI = 10240, S_CI = 27648, S_MI = 45056, S_SI = 54272, SSD_LDS = 62976;
__device__ __forceinline__ f32x4 mfma16(bf16x8 a, bf16x8 b, f32x4 c) { return __builtin_amdgcn_mfma_f32_16x16x32_bf16(a, b, c, 0, 0, 0); }
#define SSD_BAR() do { asm volatile("s_waitcnt lgkmcnt(0)" ::: "memory"); __builtin_amdgcn_s_barrier(); asm volatile("" ::: "memory"); } while (0)


constexpr int SX2_LD = 144, S_XI2 = 0;
__device__ __forceinline__ void ssd_pre(const bf16* XBC, const float* DT, const float* dt_bias, const float* a_log, const float* d_skip, bf16* MIXRAW, float* WL, float* EL, LAS unsigned char* L, int tid, int bx, int G) {
    asm volatile("" : "+v"(tid));
    const int lane = tid & 63, w = __builtin_amdgcn_readfirstlane(tid >> 6);
    const int fr = lane & 15, fq = lane >> 4, q4 = fr >> 2, p4 = fr & 3;
    constexpr int P_SET = 45056, P_MI = 2 * P_SET;
    for (int i = tid; i < 9216 / 16; i += 512) *(LAS v4u*)(L + P_MI + i * 16) = (v4u){0u, 0u, 0u, 0u};
    const int brow = tid >> 4, bch = tid & 15, xrow = tid >> 3, xch = tid & 7;
    constexpr int NIT = BATCH * 32 * 16;
    v4u bq[2], cq[2], xq; float dtr_n = 0.f, al_n = 0.f, db_n = 0.f, ds_n = 0.f;
#define PRE_LOAD(it) do { const int b_ = (it) >> 9, c_ = ((it) >> 4) & 31, h_ = (it) & 15, g_ = h_ >> 2; const bf16* src_ = XBC + (size_t)(b_ * SEQ + c_ * 64) * 2048; \
        const bf16* p_ = src_ + (size_t)brow * 2048 + 1024 + g_ * 128 + bch * 8; \
        bq[0] = *(const v4u*)p_; cq[0] = *(const v4u*)(p_ + 512); bq[1] = *(const v4u*)(p_ + 32 * 2048); cq[1] = *(const v4u*)(p_ + 32 * 2048 + 512); \
        xq = *(const v4u*)(src_ + (size_t)xrow * 2048 + h_ * 64 + xch * 8); dtr_n = DT[(size_t)(b_ * SEQ + c_ * 64 + lane) * 16 + h_]; al_n = a_log[h_]; db_n = dt_bias[h_]; ds_n = d_skip[h_]; } while (0)
#define PRE_STAGE(set) do { LAS unsigned char* Ls_ = L + (set) * P_SET; \
        *(LAS v4u*)(Ls_ + S_BI + brow * SB_LD + bch * 16) = bq[0]; *(LAS v4u*)(Ls_ + S_CI + brow * SB_LD + bch * 16) = cq[0]; \
        *(LAS v4u*)(Ls_ + S_BI + (brow + 32) * SB_LD + bch * 16) = bq[1]; *(LAS v4u*)(Ls_ + S_CI + (brow + 32) * SB_LD + bch * 16) = cq[1]; \
        *(LAS v4u*)(Ls_ + S_XI2 + xrow * SX2_LD + xch * 16) = xq; } while (0)
    if (bx >= NIT) return;
    PRE_LOAD(bx);
    PRE_STAGE(0);
    float dtr_c = dtr_n, al_c = al_n, db_c = db_n, ds_c = ds_n;
    SSD_BAR();
    int set = 0;
    for (int item = bx; item < NIT; item += G, set ^= 1) {
        const int b = item >> 9, c = (item >> 4) & 31, h = item & 15;
        const LAS unsigned char* Ls = L + set * P_SET;
        const bool more = item + G < NIT;
        if (more) PRE_LOAD(item + G);
        const float a = -fexp(al_c), dtb = db_c, Dh = ds_c;
        const int row0 = b * SEQ + c * 64;
        const float dt = softplus_f(dtr_c + dtb);
        float cs = dt * a;
#pragma unroll
        for (int o = 1; o < 64; o <<= 1) { const float t = __shfl_up(cs, o); if (lane >= o) cs += t; }
        const float cs63 = __shfl(cs, 63);
        if (w == 0) { const size_t ti = (size_t)(b * 16 + h) * SEQ + c * 64 + lane; WL[ti] = dt * fexp(cs63 - cs); EL[ti] = fexp(cs); }
#pragma unroll 1
        for (int t = w; t < 10; t += 8) {
            const int lt = (t >= 6) ? 3 : (t >= 3) ? 2 : (t >= 1) ? 1 : 0, st = t - (lt * (lt + 1)) / 2;
            const float csl = __shfl(cs, lt * 16 + fr);
            f32x4 acc = {0.f, 0.f, 0.f, 0.f};
#pragma unroll
            for (int ks = 0; ks < 4; ++ks) { const bf16x8 af = *(const LAS bf16x8*)(Ls + S_BI + (st * 16 + fr) * SB_LD + ks * 64 + fq * 16), bfr = *(const LAS bf16x8*)(Ls + S_CI + (lt * 16 + fr) * SB_LD + ks * 64 + fq * 16);
                acc = mfma16(af, bfr, acc); }
            float v[4];
#pragma unroll
            for (int j = 0; j < 4; ++j) { const int s = st * 16 + 4 * fq + j; const float css = __shfl(cs, s), dts = __shfl(dt, s);
                v[j] = (s <= lt * 16 + fr) ? acc[j] * fexp(csl - css) * dts : 0.f; }
            v2u mw; mw.x = pk2(v[0], v[1]); mw.y = pk2(v[2], v[3]);
            *(LAS v2u*)(L + P_MI + (lt * 16 + fr) * SM_LD + (st * 16 + 4 * fq) * 2) = mw;
        }
        SSD_BAR();
#pragma unroll
        for (int tt = 0; tt < 2; ++tt) {
            const int id = w * 2 + tt, pt = id >> 2, lt = id & 3;
            f32x4 yd = {0.f, 0.f, 0.f, 0.f};
#pragma unroll
            for (int ks = 0; ks < 2; ++ks) if (2 * ks <= lt) {
                const LAS unsigned char* xa = Ls + S_XI2 + (ks * 32 + fq * 8 + q4) * SX2_LD + (pt * 16 + 4 * p4) * 2;
                const bf16x8 af = cat8(vtr(xa), vtr(xa + 4 * SX2_LD)), bfr = *(const LAS bf16x8*)(L + P_MI + (lt * 16 + fr) * SM_LD + ks * 64 + fq * 16);
                yd = mfma16(af, bfr, yd); }
            const int l = lt * 16 + fr;
            const v2u xv = *(const LAS v2u*)(Ls + S_XI2 + l * SX2_LD + (pt * 16 + 4 * fq) * 2);
            v2u yw; yw.x = pk2(yd[0] + Dh * bflo(xv.x), yd[1] + Dh * bfhi(xv.x)); yw.y = pk2(yd[2] + Dh * bflo(xv.y), yd[3] + Dh * bfhi(xv.y));
            *(v2u*)(MIXRAW + (size_t)(row0 + (l & ~1) + (pt >> 1)) * 2048 + 1024 + h * 64 + (l & 1) * 32 + (pt & 1) * 16 + 4 * fq) = yw;
        }
        if (more) { PRE_STAGE(set ^ 1); dtr_c = dtr_n; al_c = al_n; db_c = db_n; ds_c = ds_n; }
        SSD_BAR();
    }
#undef PRE_LOAD
#undef PRE_STAGE
}
__device__ __forceinline__ void ssd_scan(int unit, const bf16* XBC, const float* WL, const float* EL, bf16* MIXRAW, LAS unsigned char* L, int tid) {
    asm volatile("" : "+v"(tid));
    const int lane = tid & 63, w = __builtin_amdgcn_readfirstlane(tid >> 6);
    const int b = unit >> 5, h = (unit >> 1) & 15, ph = unit & 1, g = h >> 2;
    const int fr = lane & 15, fq = lane >> 4, q4 = fr >> 2, p4 = fr & 3;
    f32x4 sacc[2] = {(f32x4){0.f, 0.f, 0.f, 0.f}, (f32x4){0.f, 0.f, 0.f, 0.f}};
    const bf16* src0 = XBC + (size_t)(b * SEQ) * 2048;
    const float* wl0 = WL + (size_t)(b * 16 + h) * SEQ; const float* el0 = EL + (size_t)(b * 16 + h) * SEQ;
    const int brow = tid >> 4, bch = tid & 15, xrow = (tid & 255) >> 2, xch = tid & 3;
    const int ypt = w >> 2, ylt = w & 3, yl = ylt * 16 + fr;
    bf16* yp0 = MIXRAW + (size_t)(b * SEQ + (yl & ~1) + ph) * 2048 + 1024 + h * 64 + (yl & 1) * 32 + ypt * 16 + 4 * fq;
    constexpr int PF = 4;
    v4u bq[PF][2], cq[PF][2], xq[PF]; v2u yq[PF]; float wlq[PF], elq[PF], e63q[PF];
#define SCAN_LOAD(k, cc) do { const int t1_ = (cc) * 64; const bf16* p_ = src0 + (size_t)(t1_ + brow) * 2048 + 1024 + g * 128 + bch * 8; \
        bq[k][0] = *(const v4u*)p_; cq[k][0] = *(const v4u*)(p_ + 512); bq[k][1] = *(const v4u*)(p_ + 32 * 2048); cq[k][1] = *(const v4u*)(p_ + 32 * 2048 + 512); \
        xq[k] = *(const v4u*)(src0 + (size_t)(t1_ + xrow) * 2048 + h * 64 + ph * 32 + xch * 8); \
        wlq[k] = wl0[t1_ + xrow]; elq[k] = el0[t1_ + yl]; e63q[k] = el0[t1_ + 63]; yq[k] = *(const v2u*)(yp0 + (size_t)t1_ * 2048); } while (0)
    constexpr int Q_XW = 0, Q_B = 5120, Q_C = 22528, Q_S = 39936, Q_SET = 49152;
#define SCAN_STAGE(k, set) do { LAS unsigned char* Ls_ = L + (set) * Q_SET; \
        *(LAS v4u*)(Ls_ + Q_B + brow * SB_LD + bch * 16) = bq[k][0]; *(LAS v4u*)(Ls_ + Q_C + brow * SB_LD + bch * 16) = cq[k][0]; \
        *(LAS v4u*)(Ls_ + Q_B + (brow + 32) * SB_LD + bch * 16) = bq[k][1]; *(LAS v4u*)(Ls_ + Q_C + (brow + 32) * SB_LD + bch * 16) = cq[k][1]; \
        if (w < 4) { const float wr_ = wlq[k]; const v4u xv4_ = xq[k]; v4u xw_; \
            xw_.x = pk2(bflo(xv4_.x) * wr_, bfhi(xv4_.x) * wr_); xw_.y = pk2(bflo(xv4_.y) * wr_, bfhi(xv4_.y) * wr_); xw_.z = pk2(bflo(xv4_.z) * wr_, bfhi(xv4_.z) * wr_); xw_.w = pk2(bflo(xv4_.w) * wr_, bfhi(xv4_.w) * wr_); \
            *(LAS v4u*)(Ls_ + Q_XW + xrow * SX_LD + xch * 16) = xw_; } \
        _Pragma("unroll") for (int pt_ = 0; pt_ < 2; ++pt_) { const f32x4 v_ = sacc[pt_]; v2u sw_; sw_.x = pk2(v_[0], v_[1]); sw_.y = pk2(v_[2], v_[3]); \
            *(LAS v2u*)(Ls_ + Q_S + (pt_ * 16 + fr) * SB_LD + (w * 16 + 4 * fq) * 2) = sw_; } } while (0)
#pragma unroll
    for (int k = 0; k < PF; ++k) SCAN_LOAD(k, k);
    SCAN_STAGE(0, 0);
    SSD_BAR();
    for (int c0 = 0; c0 < 32; c0 += PF) {
#pragma unroll
      for (int k = 0; k < PF; ++k) {
        const int c = c0 + k;
        const LAS unsigned char* Lc = L + (k & 1) * Q_SET;
        const float el = elq[k], e63 = e63q[k]; const v2u yv = yq[k];
        {   f32x4 yo = {0.f, 0.f, 0.f, 0.f};
#pragma unroll
            for (int ks = 0; ks < 4; ++ks) { const bf16x8 af = *(const LAS bf16x8*)(Lc + Q_S + (ypt * 16 + fr) * SB_LD + ks * 64 + fq * 16), bfr = *(const LAS bf16x8*)(Lc + Q_C + (ylt * 16 + fr) * SB_LD + ks * 64 + fq * 16);
                yo = mfma16(af, bfr, yo); }
            v2u yw; yw.x = pk2(bflo(yv.x) + el * yo[0], bfhi(yv.x) + el * yo[1]); yw.y = pk2(bflo(yv.y) + el * yo[2], bfhi(yv.y) + el * yo[3]);
            *(v2u*)(yp0 + (size_t)(c * 64) * 2048) = yw; }
#pragma unroll
        for (int pt = 0; pt < 2; ++pt) {
            f32x4 acc = sacc[pt] * e63;
#pragma unroll
            for (int ks = 0; ks < 2; ++ks) {
                const LAS unsigned char* ba = Lc + Q_B + (ks * 32 + fq * 8 + q4) * SB_LD + (w * 16 + 4 * p4) * 2;
                const LAS unsigned char* xa = Lc + Q_XW + (ks * 32 + fq * 8 + q4) * SX_LD + (pt * 16 + 4 * p4) * 2;
                acc = mfma16(cat8(vtr(ba), vtr(ba + 4 * SB_LD)), cat8(vtr(xa), vtr(xa + 4 * SX_LD)), acc); }
            sacc[pt] = acc; }
        if (c + 1 < 32) SCAN_STAGE((k + 1) % PF, (k + 1) & 1);
        if (c + PF < 32) SCAN_LOAD(k, c + PF);
        SSD_BAR();
      }
    }
#undef SCAN_STAGE
#undef SCAN_LOAD
}

#define XB_TMO      128
#define XB_XCNT(j)  (256  + 64 * (j))
#define XB_XSUB(j)  (1280 + 64 * (j))
#define XB_XGEN(j)  (2304 + 64 * (j))
#define XB_TOP      3328
#define XB_TOPGEN   3392
#define XCD_BAR_WORDS 3456
#define XB_SPIN_CAP (1u << 18)

__device__ __forceinline__ unsigned xb_ld(unsigned* p)              { return __hip_atomic_load(p, __ATOMIC_RELAXED, __HIP_MEMORY_SCOPE_AGENT); }
__device__ __forceinline__ unsigned xb_add(unsigned* p, unsigned v) { return __hip_atomic_fetch_add(p, v, __ATOMIC_RELAXED, __HIP_MEMORY_SCOPE_AGENT); }
__device__ __forceinline__ unsigned xb_xcc_id() { return (unsigned)__builtin_amdgcn_s_getreg((3 << 11) | 20) & 0xFu; }
#define XB_SPIN(cond, bar) do { unsigned _sp = 0; while (cond) { __builtin_amdgcn_s_sleep(1); \
    if ((++_sp & 255u) == 0u) { if (xb_ld(&(bar)[XB_TMO])) break; if (_sp > XB_SPIN_CAP) { atomicAdd(&(bar)[XB_TMO], 1u); break; } } } } while (0)

struct XcdBarrier {
    unsigned* bar; unsigned x; unsigned w0;
    volatile LAS unsigned* st;
};

__device__ __forceinline__ XcdBarrier xcd_barrier_post(unsigned* bar, volatile LAS unsigned* st) {
    XcdBarrier b; b.bar = bar; b.x = xb_xcc_id(); b.st = st;
    if (threadIdx.x == 0) (void)xb_add(&bar[XB_XCNT(b.x)], 1u);
    return b;
}
__device__ __forceinline__ void xcd_barrier_complete(unsigned* bar, unsigned x, unsigned& nloc, unsigned& nx) {
    const unsigned G = gridDim.x * gridDim.y * gridDim.z;
    unsigned sum, cnt, mine, sp = 0u;
    for (;;) {
        sum = 0u; cnt = 0u; mine = 0u;
#pragma unroll
        for (unsigned j = 0; j < 16; ++j) { const unsigned c = xb_ld(&bar[XB_XCNT(j)]); sum += c; cnt += (c > 0u) ? 1u : 0u; mine = (j == x) ? c : mine; }
        if (sum == G) break;
        __builtin_amdgcn_s_sleep(1);
        if ((++sp & 255u) == 0u) { if (xb_ld(&bar[XB_TMO])) break; if (sp > XB_SPIN_CAP) { atomicAdd(&bar[XB_TMO], 1u); break; } }
    }
    nloc = mine > 0u ? mine : 1u; nx = cnt > 0u ? cnt : 1u;
}

__device__ __forceinline__ void xcd_barrier(const XcdBarrier& b) {
    asm volatile("s_waitcnt vmcnt(0)" ::: "memory");
    __syncthreads();
    if (b.w0 && pg8::hw_lane() == 0) {
        unsigned* bar = b.bar;
        __builtin_amdgcn_s_waitcnt(0);
        unsigned nloc = b.st[0], nx = b.st[1];
        if (nloc == 0u) { xcd_barrier_complete(bar, b.x, nloc, nx); b.st[0] = nloc; b.st[1] = nx; }
        const unsigned old = xb_add(&bar[XB_XSUB(b.x)], 1u);
        const unsigned gen = old / nloc;
        if (old + 1u == (gen + 1u) * nloc) {
            __builtin_amdgcn_fence(__ATOMIC_RELEASE, "agent");
            asm volatile("s_waitcnt vmcnt(0)" ::: "memory");
            const unsigned og = xb_add(&bar[XB_TOP], 1u);
            const unsigned tg = og / nx;
            if (og + 1u == (tg + 1u) * nx) xb_add(&bar[XB_TOPGEN], 1u);
            else XB_SPIN(xb_ld(&bar[XB_TOPGEN]) == tg, bar);
            __builtin_amdgcn_fence(__ATOMIC_ACQUIRE, "agent");
            xb_add(&bar[XB_XGEN(b.x)], 1u);
            asm volatile("s_waitcnt vmcnt(0)" ::: "memory");
        } else {
            XB_SPIN(xb_ld(&bar[XB_XGEN(b.x)]) == gen, bar);
            __builtin_amdgcn_fence(__ATOMIC_ACQUIRE, "agent");
            asm volatile("s_waitcnt vmcnt(0)" ::: "memory");
        }
    }
    __syncthreads();
}

__global__ void __launch_bounds__(NWAVES * 64, 2) fwd_megakernel(Args A) {
    extern __shared__ __attribute__((aligned(16))) unsigned char lds_raw[];
    cg::grid_group grid = cg::this_grid();
    LAS unsigned char* lds = (LAS unsigned char*)lds_raw;
    const int wave = __builtin_amdgcn_readfirstlane((int)threadIdx.x >> 6); int lane = pg8::hw_lane();
#define tid (wave * 64 + lane)
#define PHASE_FENCE() do { lane = pg8::hw_lane(); asm volatile("" : "+v"(lane)); } while (0)
    const int G = gridDim.x, bx = blockIdx.x;
    const int gw = bx * NWAVES + wave, NGW = G * NWAVES;
    unsigned char* ws = A.ws;
    bf16* U = (bf16*)(ws + WS_U); bf16* Y = (bf16*)(ws + WS_Y); bf16* BIG = (bf16*)(ws + WS_BIG);
    bf16* QM = (bf16*)(ws + WS_QM); bf16* OM = (bf16*)(ws + WS_OM); bf16* KVM = (bf16*)(ws + WS_KVM); float* DT = (float*)(ws + WS_DT);
    float* H = A.out; bf16* H16 = (bf16*)A.out; float* RS = (float*)(ws + WS_RS);
    typedef pg8::StaticOrder SO;
    if (tid < 64) ((LAS unsigned*)(lds + 131072))[tid] = 0u;
    __syncthreads();
    XcdBarrier xbar; xbar.bar = (unsigned*)(ws + WS_CTL); xbar.x = xb_xcc_id(); xbar.st = (volatile LAS unsigned*)(lds + 131072); xbar.w0 = (wave == 0) ? 1u : 0u;
    if (tid == 0) ((volatile LAS unsigned*)(lds + 131072))[4] = xb_add(&xbar.bar[XB_XCNT(xbar.x)], 1u);
    __syncthreads();
    const int xrank = (int)((volatile LAS unsigned*)(lds + 131072))[4], xcc = (int)xbar.x;
#define GRID_BAR() do { xcd_barrier(xbar); PHASE_FENCE(); } while (0)

    p0_prologue(A, lds, gw, NGW, wave, lane);
    if (G > (1 << 20)) grid.sync();
    GRID_BAR();
    bool okmap = (G % 8 == 0) && xcc < 8 && xrank < G / 8;
#pragma unroll
    for (int j = 0; j < 8; ++j) okmap = okmap && (xb_ld(&xbar.bar[XB_XCNT(j)]) == (unsigned)(G / 8));
    okmap = __syncthreads_and(okmap ? 1 : 0) != 0;
    const int cx = __builtin_amdgcn_readfirstlane(okmap ? xrank * 8 + xcc : bx);
    const int vcu = __builtin_amdgcn_readfirstlane(okmap ? xcc * (G / 8) + xrank : bx);
    { pg8::Gemm g{U, (const bf16*)(ws + WS_W1GU), T, 2 * FF, D, D}; g.wid = wave; SO S; S.init(T, 2 * FF, G, cx); pg8::EpiSwiGLU E{BIG, FF, RS};
      pg8::gemm_phase<pg8::EpiSwiGLU, SO, true, true>(lds, g, S, E); }
    __syncthreads();
    { pg8::Gemm g{(const bf16*)(ws + WS_MN), (const bf16*)(ws + WS_WMKV), BATCH * NMEM, 2 * MEMW, D, D}; g.wid = wave; SO S; S.init(BATCH * NMEM, 2 * MEMW, G, (cx + 32) % G); pg8::EpiBf16 E{KVM, 2 * MEMW, nullptr};
      pg8::gemm_phase<pg8::EpiBf16, SO, true, true>(lds, g, S, E); }
    GRID_BAR();
    { pg8::Gemm g{BIG, (const bf16*)(ws + WS_W1D), T, D, FF, FF}; g.wid = wave; SO S; S.init(T, D, G, cx); pg8::EpiBf16 E{Y, D, nullptr};
      pg8::gemm_phase<pg8::EpiBf16, SO, true, true>(lds, g, S, E); }
    GRID_BAR();
    norm_phase<true, true, false>(Y, A.in[0], nullptr, H16, nullptr, A.in[6], 0.5f, RS, gw, NGW, lane);
    GRID_BAR();
    { pg8::Gemm g{H16, (const bf16*)(ws + WS_WIN), T, PROJ_LD, D, D}; g.wid = wave; SO S; S.init(T, PROJ_LD, G, cx); pg8::EpiBf16 E{BIG, PROJ_LD, RS};
      pg8::gemm_phase<pg8::EpiBf16, SO, true, true>(lds, g, S, E); }
    GRID_BAR();
    {   LAS unsigned char* vimg = lds + wave * VIMG_BYTES;
#pragma unroll 1
        for (int stage = 0; stage < 2; ++stage) {
            if (((wave & 1) != 0) == (stage == 0)) {
                for (int u = gw; u < BATCH * 8 * 64; u += NGW) {
                    const int qb = u & 63, hh = (u >> 6) & 7, b = u >> 9;
                    const bf16* base = BIG + (size_t)b * SEQ * PROJ_LD + hh * 128;
                    attn_unit<0>(base + QOFF, PROJ_LD, base + KOFF, base + VOFF, PROJ_LD, qb * 32, qb, U + (size_t)b * SEQ * D + hh * 128, D, vimg, lane);
                }
            } else {
                conv_phase(BIG, A.in[9], A.in[10], Y, gw, NGW, lane);
                if ((wave & 1) == 0) dt_phase(H16, D, RS, (const bf16*)(ws + WS_WIN) + (size_t)PROJ_LD * D, DT, gw >> 1, NGW >> 1, lane);
            }
            PHASE_FENCE();
        } }
    GRID_BAR();
    ssd_pre(Y, DT, A.in[11], A.in[12], A.in[13], U, (float*)(ws + WS_WL), (float*)(ws + WS_EL), lds, tid, vcu, G);
    GRID_BAR();
    for (int unit = vcu; unit < BATCH * 32; unit += G) ssd_scan(unit, Y, (const float*)(ws + WS_WL), (const float*)(ws + WS_EL), U, lds, tid);
    GRID_BAR();
    mixnorm_phase(U, BIG, A.in[14], A.in[15], gw, NGW, lane);
    GRID_BAR();
    { pg8::Gemm g{U, (const bf16*)(ws + WS_WOUT), T, D, D, D}; g.wid = wave; SO S; S.init(T, D, G, cx); pg8::EpiBf16 E{Y, D, nullptr};
      pg8::gemm_phase<pg8::EpiBf16, SO, true, true>(lds, g, S, E); }
    GRID_BAR();
    norm_phase<true, false, false>(Y, nullptr, H16, H16, nullptr, A.in[17], 1.0f, RS, gw, NGW, lane);
    GRID_BAR();
    { constexpr int NU = (T / 256) * (MEMW / 256);
      if (cx < NU || G <= NU) { pg8::Gemm g{H16, (const bf16*)(ws + WS_WMQ), T, MEMW, D, D}; g.wid = wave; SO S; S.init(T, MEMW, G, cx); pg8::EpiBf16 E{QM, MEMW, RS};
      pg8::gemm_phase<pg8::EpiBf16, SO, true, true>(lds, g, S, E); }
      if (G <= NU) { __syncthreads(); ffn2_weights(A, lds, gw, NGW, wave, lane); }
      else if (cx >= NU) ffn2_weights(A, lds, (cx - NU) * NWAVES + wave, (G - NU) * NWAVES, wave, lane); }
    GRID_BAR();
    { LAS unsigned char* vimg = lds + wave * VIMG_BYTES;
      for (int u = gw; u < BATCH * 4 * 64; u += NGW) {
          const int qb = u & 63, hh = (u >> 6) & 3, b = u >> 8;
          const bf16* kv = KVM + (size_t)b * NMEM * (2 * MEMW) + hh * 128;
          attn_unit<1>(QM + (size_t)b * SEQ * MEMW + hh * 128, MEMW, kv, kv + MEMW, 2 * MEMW, qb * 32, NMEM / 32 - 1, OM + (size_t)b * SEQ * MEMW + hh * 128, MEMW, vimg, lane);
      } }
    GRID_BAR();
    { pg8::Gemm g{OM, (const bf16*)(ws + WS_WMO), T, D, MEMW, MEMW}; g.wid = wave; SO S; S.init(T, D, G, cx); pg8::EpiBf16 E{Y, D, nullptr};
      pg8::gemm_phase<pg8::EpiBf16, SO, true, true>(lds, g, S, E); }
    GRID_BAR();
    norm_phase<true, false, false, true>(Y, nullptr, H16, U, nullptr, A.in[23], 1.0f, RS, gw, NGW, lane, (unsigned char*)BIG + 96 * MiB);
    for (int i = gw * 64 + lane; i < T * 8; i += NGW * 64) *(v4u*)((unsigned char*)BIG + (size_t)(i >> 3) * ACT8_LD + FF + (i & 7) * 16) = (v4u){0u, 0u, 0u, 0u};
    GRID_BAR();
    { pg8::Gemm g{(const bf16*)((unsigned char*)BIG + 96 * MiB), (const bf16*)(ws + WS_W2GU), T, 2 * FF, D / 2, D / 2}; g.wid = wave; SO S; S.init(T, 2 * FF, G, cx);
      pg8::EpiSwiGLU8 E{(unsigned char*)BIG, ACT8_LD, 1.0f / W2GU_SCALE};
      pg8::gemm_phase<pg8::EpiSwiGLU8, SO, true, true, true>(lds, g, S, E); }
    GRID_BAR();
    { pg8::Gemm g{BIG, (const bf16*)(ws + WS_W2D), T, D, ACT8_LD / 2, ACT8_LD / 2}; g.wid = wave; SO S; S.init(T, D, G, cx); pg8::EpiBf16S E{Y, D, 1.0f / W2D_SCALE};
      pg8::gemm_phase<pg8::EpiBf16S, SO, true, true, true>(lds, g, S, E); }
    GRID_BAR();
    norm_phase<false, false, true>(Y, nullptr, U, nullptr, H, A.in[28], 0.5f, nullptr, gw, NGW, lane);
}

#undef tid
extern "C" void kernel_launch(void* const* d_in, const int* in_sizes, int n_in, void* d_out, int out_size, void* d_ws, size_t ws_size, hipStream_t stream) {
    static int grid = 0;
    if (grid == 0) {
        if (n_in != 29 || in_sizes[0] != T * D || out_size != T * D || ws_size < WS_TOP2) { fprintf(stderr, "kernel_launch: unexpected problem: n_in %d in0 %d out %d ws %zu (need %zu)\n", n_in, n_in > 0 ? in_sizes[0] : -1, out_size, ws_size, (size_t)WS_END); grid = -1; return; }
        int dev = 0, cus = 0, per_cu = 0;
        hipGetDevice(&dev); hipDeviceGetAttribute(&cus, hipDeviceAttributeMultiprocessorCount, dev);
        if (hipFuncSetAttribute((const void*)fwd_megakernel, hipFuncAttributeMaxDynamicSharedMemorySize, LDS_BYTES) != hipSuccess) { fprintf(stderr, "kernel_launch: hipFuncSetAttribute failed\n"); grid = -1; return; }
        if (hipOccupancyMaxActiveBlocksPerMultiprocessor(&per_cu, (const void*)fwd_megakernel, NWAVES * 64, LDS_BYTES) != hipSuccess || per_cu < 1) { fprintf(stderr, "kernel_launch: occupancy query says %d blocks per CU\n", per_cu); per_cu = 1; }
        (void)hipGetLastError();
        grid = cus * per_cu;
    }
    if (grid < 0) return;
    if (hipMemsetAsync((char*)d_ws + WS_CTL, 0, CTL_BYTES, stream) != hipSuccess) { fprintf(stderr, "kernel_launch: hipMemsetAsync failed\n"); return; }
    Args a{};
    for (int i = 0; i < 29; ++i) a.in[i] = (const float*)d_in[i];
    a.out = (float*)d_out; a.ws = (unsigned char*)d_ws;
    void* args[] = {&a};
    hipError_t e = hipLaunchCooperativeKernel((const void*)fwd_megakernel, dim3(grid), dim3(NWAVES * 64), args, LDS_BYTES, stream);
    if (e != hipSuccess) fprintf(stderr, "kernel_launch: cooperative launch failed: %s (grid %d)\n", hipGetErrorString(e), grid);
}
```
